# Optimizing an MI355X kernel written in HIP

```python
import jax, jax.numpy as jnp
from jax import lax
import numpy as np

D_MODEL = 1024
BATCH = 8
SEQ = 2048
DEPTH = 4
DEC_BATCH = 128
DEC_SEQ = 4
PAST_LEN = 2048
PAGE_SIZE = 128

N_MIXERS = 2
N_A_LAYERS = (DEPTH + N_MIXERS - 1) // N_MIXERS
N_B_LAYERS = DEPTH // N_MIXERS
CHUNK = 128
D_A = D_MODEL
N_GROUPS_A = 8
GROUP_DIM_A = D_A // N_GROUPS_A
N_HEADS = 8
HEAD_DIM = D_MODEL // N_HEADS
N_KV_HEADS = 2
N_IDX_HEADS = 8
IDX_DIM = 64
TOPK_MAX = 256
QUERY_BLOCK = 128
ROPE_THETA = 500000.0
ROT_DIV = 4
IDX_SCALE = float((IDX_DIM * N_IDX_HEADS) ** -0.5)
ATTN_SCALE = float(HEAD_DIM ** -0.5)
Q_W = N_HEADS * HEAD_DIM
KV_W = N_KV_HEADS * HEAD_DIM
QI_W = N_IDX_HEADS * IDX_DIM
B_PROJ = Q_W + 2 * KV_W + QI_W + IDX_DIM + N_IDX_HEADS
D_FF = 4 * D_MODEL
EPS = 1e-6

kernel_name = 'dsa_chunkmlp_hybrid_step'


def rms_norm(x, g):
    xf = x.astype(jnp.float32)
    y = xf * lax.rsqrt(jnp.mean(xf * xf, axis=-1, keepdims=True) + EPS)
    return y.astype(x.dtype) * g


def rope(x, pos):
    dim = x.shape[-1]
    r = dim // ROT_DIV
    half = r // 2
    inv = ROPE_THETA ** (-jnp.arange(half, dtype=jnp.float32) * 2.0 / r)
    ang = pos.astype(jnp.float32)[:, None] * inv[None, :]
    cos = jnp.cos(ang)[None, :, None, :]
    sin = jnp.sin(ang)[None, :, None, :]
    xr = x[..., :r].astype(jnp.float32)
    x1, x2 = xr[..., :half], xr[..., half:]
    rot = jnp.concatenate([x1 * cos - x2 * sin, x2 * cos + x1 * sin], axis=-1).astype(x.dtype)
    return jnp.concatenate([rot, x[..., r:]], axis=-1)


def sqrelu_mlp(h, w1, w2):
    a = jax.nn.relu(h @ w1)
    return (a * a) @ w2


def chunk_mlp(h, w_in, v_gain, w_s, b_s, w_out):
    N, T, _ = h.shape
    uv = jax.nn.gelu(h @ w_in)
    u, v = uv[..., :D_A], uv[..., D_A:]
    vf = v.astype(jnp.float32)
    mu = jnp.mean(vf, axis=-1, keepdims=True)
    var = jnp.mean(jnp.square(vf - mu), axis=-1, keepdims=True)
    v = ((vf - mu) * lax.rsqrt(var + EPS)).astype(h.dtype) * v_gain
    c = CHUNK if T >= CHUNK else T
    n_chunks = -(-T // c)
    tp = n_chunks * c
    vp = jnp.pad(v, ((0, 0), (0, tp - T), (0, 0))).reshape(N, n_chunks, c, N_GROUPS_A, GROUP_DIM_A)
    mask = jnp.tril(jnp.ones((c, c), dtype=bool))
    ws = jnp.where(mask[None], w_s[:, :c, :c], jnp.zeros((), w_s.dtype))
    mixed = jnp.einsum('gts,ncsgd->nctgd', ws, vp) + b_s[:, :c].T[None, None, :, :, None]
    mixed = mixed.reshape(N, tp, D_A)[:, :T]
    out = (u * mixed) @ w_out
    start = ((T - 1) // CHUNK) * CHUNK
    return out, v[:, start:]


def dsa_project(h, w_in, pos):
    N, T, _ = h.shape
    p = h @ w_in
    o1 = Q_W
    o2 = o1 + KV_W
    o3 = o2 + KV_W
    o4 = o3 + QI_W
    o5 = o4 + IDX_DIM
    q = rope(p[..., :o1].reshape(N, T, N_HEADS, HEAD_DIM), pos)
    k = rope(p[..., o1:o2].reshape(N, T, N_KV_HEADS, HEAD_DIM), pos)
    v = p[..., o2:o3].reshape(N, T, N_KV_HEADS, HEAD_DIM)
    qi = rope(p[..., o3:o4].reshape(N, T, N_IDX_HEADS, IDX_DIM), pos)
    ki = rope(p[..., o4:o5].reshape(N, T, 1, IDX_DIM), pos)[:, :, 0]
    wi = p[..., o5:]
    return q, k, v, qi, ki, wi


def index_scores(qi, wi, ki):
    dots = jnp.einsum('nthd,nsd->nths', qi, ki, preferred_element_type=jnp.float32)
    return jnp.einsum('nths,nth->nts', jax.nn.relu(dots), wi.astype(jnp.float32)) * IDX_SCALE


def attend(q, kg, vg, valid):
    N, T = q.shape[0], q.shape[1]
    qg = q.reshape(N, T, N_KV_HEADS, N_HEADS // N_KV_HEADS, HEAD_DIM)
    s = jnp.einsum('ntkgd,ntjkd->ntkgj', qg, kg, preferred_element_type=jnp.float32) * ATTN_SCALE
    s = jnp.where(valid[:, :, None, None, :], s, -jnp.inf)
    p = jax.nn.softmax(s, axis=-1)
    o = jnp.einsum('ntkgj,ntjkd->ntkgd', p.astype(vg.dtype), vg)
    return o.reshape(N, T, N_HEADS * HEAD_DIM).astype(q.dtype)


def dsa_prompt(h, w_in, w_out):
    N, T, _ = h.shape
    pos = jnp.arange(T)
    q, k, v, qi, ki, wi = dsa_project(h, w_in, pos)
    qb = min(QUERY_BLOCK, T)
    nb = T // qb
    k_top = min(TOPK_MAX, T // 4)
    bi = jnp.arange(N)[:, None, None]

    def block(args):
        q_b, qi_b, wi_b, start = args
        tq = start + jnp.arange(qb)
        sc = index_scores(qi_b, wi_b, ki)
        sc = jnp.where(pos[None, None, :] <= tq[None, :, None], sc, -jnp.inf)
        _, idx = lax.top_k(sc, k_top)
        valid = idx <= tq[None, :, None]
        return attend(q_b, k[bi, idx], v[bi, idx], valid)

    def to_blocks(a):
        return a.reshape(N, nb, qb, *a.shape[2:]).swapaxes(0, 1)

    o = lax.map(block, (to_blocks(q), to_blocks(qi), to_blocks(wi), jnp.arange(nb) * qb))
    o = o.swapaxes(0, 1).reshape(N, T, Q_W)
    return o @ w_out, k, v, ki


def dsa_sample(h, w_in, w_out, cache_k, cache_v, cache_kidx, page_table, layer):
    N, T, _ = h.shape
    n_pages = page_table.shape[1]
    past = n_pages * PAGE_SIZE
    pos = past + jnp.arange(T)
    q, k, v, qi, ki, wi = dsa_project(h, w_in, pos)
    past_ki = cache_kidx[layer, page_table].reshape(N, past, IDX_DIM)
    all_ki = jnp.concatenate([past_ki, ki.astype(past_ki.dtype)], axis=1)
    L = past + T
    k_top = min(TOPK_MAX, L // 4)
    sc = index_scores(qi, wi, all_ki)
    key_pos = jnp.arange(L)
    sc = jnp.where(key_pos[None, None, :] <= pos[None, :, None], sc, -jnp.inf)
    _, idx = lax.top_k(sc, k_top)
    bi = jnp.arange(N)[:, None, None]
    in_past = (idx < past)[..., None, None]
    pidx = jnp.minimum(idx, past - 1)
    page = page_table[bi, pidx // PAGE_SIZE]
    off = pidx % PAGE_SIZE
    nidx = jnp.clip(idx - past, 0, T - 1)
    kg = jnp.where(in_past, cache_k[layer, page, off], k[bi, nidx].astype(cache_k.dtype))
    vg = jnp.where(in_past, cache_v[layer, page, off], v[bi, nidx].astype(cache_v.dtype))
    valid = idx <= pos[None, :, None]
    o = attend(q, kg, vg, valid)
    return o @ w_out, k, v, ki


def setup_inputs(seed: int = 0) -> dict:
    key = jax.random.key(seed)
    ks = jax.random.split(key, 20)
    f32 = jnp.float32
    n_pages = PAST_LEN // PAGE_SIZE
    used = DEC_BATCH * n_pages
    n_pool = used + max(1, used // 4)
    nrm = lambda k, shp, s: jax.random.normal(k, shp, f32) * s
    page_table = jax.random.permutation(ks[0], n_pool)[:used].reshape(DEC_BATCH, n_pages).astype(jnp.int32)
    return {
        'x_prompt': nrm(ks[1], (BATCH, SEQ, D_MODEL), 1.0),
        'x_sample': nrm(ks[2], (DEC_BATCH, DEC_SEQ, D_MODEL), 1.0),
        'cache_k': nrm(ks[3], (N_B_LAYERS, n_pool, PAGE_SIZE, N_KV_HEADS, HEAD_DIM), 1.0),
        'cache_v': nrm(ks[4], (N_B_LAYERS, n_pool, PAGE_SIZE, N_KV_HEADS, HEAD_DIM), 1.0),
        'cache_kidx': nrm(ks[5], (N_B_LAYERS, n_pool, PAGE_SIZE, IDX_DIM), 1.0),
        'page_table': page_table,
        'norm_mix': 1.0 + nrm(ks[6], (DEPTH, D_MODEL), 0.02),
        'norm_ffn': 1.0 + nrm(ks[7], (DEPTH, D_MODEL), 0.02),
        'a_w_in': nrm(ks[8], (N_A_LAYERS, D_MODEL, 2 * D_A), D_MODEL ** -0.5),
        'a_v_gain': 1.0 + nrm(ks[9], (N_A_LAYERS, D_A), 0.02),
        'a_w_s': nrm(ks[10], (N_A_LAYERS, N_GROUPS_A, CHUNK, CHUNK), 0.5 * CHUNK ** -0.5),
        'a_b_s': 1.0 + nrm(ks[11], (N_A_LAYERS, N_GROUPS_A, CHUNK), 0.02),
        'a_w_out': nrm(ks[12], (N_A_LAYERS, D_A, D_MODEL), D_A ** -0.5),
        'b_w_in': nrm(ks[13], (N_B_LAYERS, D_MODEL, B_PROJ), D_MODEL ** -0.5),
        'b_w_out': nrm(ks[14], (N_B_LAYERS, Q_W, D_MODEL), Q_W ** -0.5),
        'ffn_w1': nrm(ks[15], (DEPTH, D_MODEL, D_FF), D_MODEL ** -0.5),
        'ffn_w2': nrm(ks[16], (DEPTH, D_FF, D_MODEL), D_FF ** -0.5),
        'norm_final': 1.0 + nrm(ks[17], (D_MODEL,), 0.02),
    }


def reference(x_prompt, x_sample, cache_k, cache_v, cache_kidx, page_table, norm_mix, norm_ffn,
              a_w_in, a_v_gain, a_w_s, a_b_s, a_w_out, b_w_in, b_w_out, ffn_w1, ffn_w2, norm_final):
    xp, xs = x_prompt, x_sample
    kp_l, vp_l, kip_l, ks_l, vs_l, kis_l, cvp_l, cvs_l = [], [], [], [], [], [], [], []
    for i in range(DEPTH):
        j = i // N_MIXERS
        hp = rms_norm(xp, norm_mix[i])
        hs = rms_norm(xs, norm_mix[i])
        if i % N_MIXERS == 0:
            op, cvp = chunk_mlp(hp, a_w_in[j], a_v_gain[j], a_w_s[j], a_b_s[j], a_w_out[j])
            os_, cvs = chunk_mlp(hs, a_w_in[j], a_v_gain[j], a_w_s[j], a_b_s[j], a_w_out[j])
            cvp_l.append(cvp)
            cvs_l.append(cvs)
        else:
            op, kp, vp, kip = dsa_prompt(hp, b_w_in[j], b_w_out[j])
            os_, ks, vs, kis = dsa_sample(hs, b_w_in[j], b_w_out[j], cache_k, cache_v, cache_kidx, page_table, j)
            kp_l.append(kp)
            vp_l.append(vp)
            kip_l.append(kip)
            ks_l.append(ks)
            vs_l.append(vs)
            kis_l.append(kis)
        xp = xp + op
        xs = xs + os_
        xp = xp + sqrelu_mlp(rms_norm(xp, norm_ffn[i]), ffn_w1[i], ffn_w2[i])
        xs = xs + sqrelu_mlp(rms_norm(xs, norm_ffn[i]), ffn_w1[i], ffn_w2[i])
    y_prompt = rms_norm(xp, norm_final)
    y_sample = rms_norm(xs, norm_final)
    new_k_prompt = jnp.stack(kp_l)
    new_v_prompt = jnp.stack(vp_l)
    new_kidx_prompt = jnp.stack(kip_l)
    new_k_sample = jnp.stack(ks_l)
    new_v_sample = jnp.stack(vs_l)
    new_kidx_sample = jnp.stack(kis_l)
    chunk_v_prompt = jnp.stack(cvp_l)
    chunk_v_sample = jnp.stack(cvs_l)
    return (y_prompt, y_sample, new_k_prompt, new_v_prompt, new_kidx_prompt, new_k_sample, new_v_sample, new_kidx_sample, chunk_v_prompt, chunk_v_sample)
```

```cpp
#include <hip/hip_runtime.h>
#include <cstdio>
#include <cstdint>
#include <cmath>
namespace pg8 {
#define PG8_LAS __attribute__((address_space(3)))
typedef unsigned short bf16_t;
typedef short bf16x8 __attribute__((ext_vector_type(8)));
typedef float f32x4 __attribute__((ext_vector_type(4)));
typedef unsigned u32x4 __attribute__((ext_vector_type(4)));
constexpr int BM = 256, BK = 64, HALF = 128, HTB = HALF * BK * 2  , STAGE_BYTES = 8 * HTB, NXCD = 8, WGM = 8;

__host__ __device__ __forceinline__ int lds_byte(int r, int c) { const int st = (r >> 4) * 2 + (c >> 5), rr = r & 15, cc = c & 31, ob = rr * 64 + cc * 2; return st * 1024 + (ob ^ (((ob >> 9) & 1) << 5)); }
__host__ __device__ __forceinline__ void stage_rc(int b, int& R, int& C) { const int st = b / 1024, sb = b % 1024, swz = sb ^ (((sb >> 9) & 1) << 5); R = (st >> 1) * 16 + swz / 64; C = (st & 1) * 32 + (swz % 64) / 2; }
__host__ __device__ __forceinline__ int perm32(int rho) { const int n = rho >> 4, i = rho & 15; return 8 * (i >> 2) + 4 * n + (i & 3); }

struct Unit { int pm, pn; };
struct Gemm { const bf16_t* A; const bf16_t* Bt; int M, N, K; };

struct StaticOrder {
    int nM, nN, nwg, G, c;
    __host__ __device__ void init(int M, int N, int G_, int c_) { nM = M / BM; nN = N / BM; nwg = nM * nN; G = G_; c = c_; }
    __host__ __device__ bool next(int i, Unit& u) const {
        const long L = (long)i * G + c; if (L >= nwg) return false;
        int wgid = (int)L; { const int q = nwg / NXCD, r = nwg % NXCD, xcd = wgid % NXCD, off = wgid / NXCD; wgid = (xcd < r ? xcd * (q + 1) : r * (q + 1) + (xcd - r) * q) + off; }
        const int nig = WGM * nN, gid = wgid / nig, fm = gid * WGM, gsz = (nM - fm) < WGM ? (nM - fm) : WGM;
        u.pm = fm + ((wgid % nig) % gsz); u.pn = (wgid % nig) / gsz; return true;
    }
    __device__ __forceinline__ void a_ready(const Unit&) const {}
    __device__ __forceinline__ void done(const Unit&) const {}
};

__device__ __forceinline__ unsigned cvt_pk_bf16(float lo, float hi) { unsigned r; asm volatile("v_cvt_pk_bf16_f32 %0, %1, %2" : "=v"(r) : "v"(lo), "v"(hi)); return r; }
template <class Epi, class Sched, bool ALIGN_EPI = false, bool SP2 = false>
__device__ __forceinline__ void gemm_phase(PG8_LAS unsigned char* lds, const Gemm g, const Sched& S, const Epi& E, const int wid_in  ) {
    int lane_; asm volatile("v_mbcnt_lo_u32_b32 %0, -1, 0\n\tv_mbcnt_hi_u32_b32 %0, -1, %0" : "=v"(lane_));
    int wid_ = wid_in; asm volatile("" : "+s"(wid_));
    const int wid = wid_, lane = lane_, tid = wid * 64 + lane, wr = wid >> 2, wc = wid & 3, fr = lane & 15, fq = lane >> 4;
    const int K = g.K, nt = K / BK;
    unsigned voffA[2], voffB[2];
#pragma unroll
    for (int i = 0; i < 2; ++i) { int R, C; stage_rc(tid * 16 + i * 8192, R, C); const int Rb = Epi::PERM ? ((R & ~31) + perm32(R & 31)) : R;
        voffA[i] = (unsigned)(R * K + C) * 2u; voffB[i] = (unsigned)(Rb * K + C) * 2u; }
    const size_t kstep = (size_t)(BK * 2);
    const size_t hstep = (size_t)HALF * K * 2;
    const size_t tstep = 2 * hstep;
    const unsigned ldsw = (unsigned)wid * 1024u;
    const int aoff = lds_byte(wr * 64 + fr, fq * 8), boff = lds_byte(wc * 32 + fr, fq * 8);
#define PG8_SA(b, h) (((b) * 2 + (h)) * HTB)
#define PG8_SB(b, h) ((4 + (b) * 2 + (h)) * HTB)
#define PG8_STAGE(bufoff, gbase, voff) do { _Pragma("unroll") for (int _i = 0; _i < 2; ++_i) \
        __builtin_amdgcn_global_load_lds((const unsigned*)((const char*)(gbase) + (voff)[_i]), (PG8_LAS unsigned*)(lds + (bufoff) + ldsw + _i * 8192), 16, 0, 0); } while (0)
#define PG8_LDA(dst, b, h) do { _Pragma("unroll") for (int m = 0; m < 4; ++m) _Pragma("unroll") for (int k = 0; k < 2; ++k) dst[m][k] = *(const PG8_LAS bf16x8*)(lds + PG8_SA(b, h) + aoff + m * 2048 + k * 1024); } while (0)
#define PG8_LDB(dst, b, h) do { _Pragma("unroll") for (int n = 0; n < 2; ++n) _Pragma("unroll") for (int k = 0; k < 2; ++k) dst[n][k] = *(const PG8_LAS bf16x8*)(lds + PG8_SB(b, h) + boff + n * 2048 + k * 1024); } while (0)
#define PG8_MMA(ai, bj, At, Bt) do { __builtin_amdgcn_s_setprio(1); _Pragma("unroll") for (int m = 0; m < 4; ++m) _Pragma("unroll") for (int n = 0; n < 2; ++n) _Pragma("unroll") for (int k = 0; k < 2; ++k) \
        acc[ai][bj][m][n] = __builtin_amdgcn_mfma_f32_16x16x32_bf16(Bt[n][k], At[m][k], acc[ai][bj][m][n], 0, 0, 0); __builtin_amdgcn_s_setprio(0); } while (0)
#define PG8_WAIT_V(n) asm volatile("s_waitcnt vmcnt(" #n ")" ::: "memory")
#define PG8_WAIT_L(n) asm volatile("s_waitcnt lgkmcnt(" #n ")" ::: "memory")
#define PG8_BAR __builtin_amdgcn_s_barrier()
#define PG8_SCHED __builtin_amdgcn_sched_barrier(0)
    Unit cur, nxt; int ui = 0;
    if (!S.next(0, cur)) return;
    f32x4 acc[2][2][4][2];
#pragma unroll
    for (int a = 0; a < 2; ++a)
#pragma unroll
        for (int b = 0; b < 2; ++b)
#pragma unroll
            for (int m = 0; m < 4; ++m)
#pragma unroll
                for (int n = 0; n < 2; ++n) acc[a][b][m][n] = (f32x4){0.f, 0.f, 0.f, 0.f};
    bf16x8 At[4][2], B0[2][2], B1[2][2];
    const char* cA = (const char*)g.A + (size_t)cur.pm * tstep; const char* cB = (const char*)g.Bt + (size_t)cur.pn * tstep;
    S.a_ready(cur);
    if constexpr (SP2) {
        PG8_STAGE(PG8_SB(0, 0), cB, voffB); PG8_STAGE(PG8_SB(0, 1), cB + hstep, voffB); PG8_STAGE(PG8_SA(0, 0), cA, voffA); PG8_STAGE(PG8_SA(0, 1), cA + hstep, voffA);
        if (wr == 1) PG8_BAR;
        PG8_WAIT_V(2); PG8_BAR;
        PG8_STAGE(PG8_SB(1, 0), cB + kstep, voffB); PG8_STAGE(PG8_SA(1, 0), cA + kstep, voffA); PG8_STAGE(PG8_SB(1, 1), cB + hstep + kstep, voffB);
        PG8_WAIT_V(6); PG8_BAR;
    } else {
        PG8_STAGE(PG8_SB(0, 0), cB, voffB); PG8_STAGE(PG8_SA(0, 0), cA, voffA); PG8_STAGE(PG8_SB(0, 1), cB + hstep, voffB); PG8_STAGE(PG8_SA(0, 1), cA + hstep, voffA);
        if (wr == 1) PG8_BAR;
        PG8_WAIT_V(4); PG8_BAR;
        PG8_STAGE(PG8_SB(1, 0), cB + kstep, voffB); PG8_STAGE(PG8_SA(1, 0), cA + kstep, voffA); PG8_STAGE(PG8_SB(1, 1), cB + hstep + kstep, voffB);
        PG8_WAIT_V(6); PG8_BAR;
    }
    for (;;) {
        const bool has_next = S.next(ui + 1, nxt);
        const char* nA = has_next ? (const char*)g.A + (size_t)nxt.pm * tstep : cA; const char* nB = has_next ? (const char*)g.Bt + (size_t)nxt.pn * tstep : cB;
        for (int t = 0; t < nt; t += 2) {
            const bool last = (t == nt - 2);
            const char* a1 = cA + (size_t)(t + 1) * kstep;
            const char* a2 = last ? nA : cA + (size_t)(t + 2) * kstep; const char* b2 = last ? nB : cB + (size_t)(t + 2) * kstep;
            const char* a3 = a2 + kstep; const char* b3 = b2 + kstep;
            if (last && has_next) S.a_ready(nxt);
            if constexpr (SP2) {
            PG8_LDB(B0, 0, 0); PG8_LDB(B1, 0, 1); PG8_SCHED; PG8_LDA(At, 0, 0); PG8_STAGE(PG8_SA(1, 1), a1 + hstep, voffA);
            PG8_WAIT_V(8); PG8_WAIT_L(0); PG8_BAR; PG8_MMA(0, 0, At, B0); PG8_MMA(0, 1, At, B1); PG8_BAR; PG8_SCHED;
            PG8_LDA(At, 0, 1); PG8_STAGE(PG8_SB(0, 0), b2, voffB); PG8_STAGE(PG8_SB(0, 1), b2 + hstep, voffB); PG8_STAGE(PG8_SA(0, 0), a2, voffA);
            PG8_WAIT_V(8); PG8_WAIT_L(0); PG8_BAR; PG8_MMA(1, 0, At, B0); PG8_MMA(1, 1, At, B1); PG8_BAR; PG8_SCHED;
            PG8_LDB(B0, 1, 0); PG8_LDB(B1, 1, 1); PG8_SCHED; PG8_LDA(At, 1, 0); PG8_STAGE(PG8_SA(0, 1), a2 + hstep, voffA);
            PG8_WAIT_V(8); PG8_WAIT_L(0); PG8_BAR; PG8_MMA(0, 0, At, B0); PG8_MMA(0, 1, At, B1); PG8_BAR; PG8_SCHED;
            PG8_LDA(At, 1, 1); PG8_STAGE(PG8_SB(1, 0), b3, voffB); PG8_STAGE(PG8_SB(1, 1), b3 + hstep, voffB); PG8_STAGE(PG8_SA(1, 0), a3, voffA);
            PG8_WAIT_V(8); PG8_WAIT_L(0); PG8_BAR; PG8_MMA(1, 0, At, B0); PG8_MMA(1, 1, At, B1); PG8_BAR; PG8_SCHED;
            } else {
            PG8_LDB(B0, 0, 0); PG8_SCHED; PG8_LDA(At, 0, 0); PG8_STAGE(PG8_SA(1, 1), a1 + hstep, voffA);
            PG8_WAIT_L(8); PG8_BAR; PG8_WAIT_L(0); PG8_MMA(0, 0, At, B0); PG8_BAR; PG8_SCHED;
            PG8_LDB(B1, 0, 1); PG8_STAGE(PG8_SB(0, 0), b2, voffB);
            PG8_BAR; PG8_WAIT_L(0); PG8_MMA(0, 1, At, B1); PG8_BAR;
            PG8_LDA(At, 0, 1); PG8_STAGE(PG8_SA(0, 0), a2, voffA);
            PG8_BAR; PG8_WAIT_L(0); PG8_MMA(1, 0, At, B0); PG8_BAR; PG8_SCHED;
            PG8_STAGE(PG8_SB(0, 1), b2 + hstep, voffB);
            PG8_WAIT_V(6); PG8_BAR; PG8_MMA(1, 1, At, B1); PG8_BAR;
            PG8_LDB(B0, 1, 0); PG8_SCHED; PG8_LDA(At, 1, 0); PG8_STAGE(PG8_SA(0, 1), a2 + hstep, voffA);
            PG8_WAIT_L(8); PG8_BAR; PG8_WAIT_L(0); PG8_MMA(0, 0, At, B0); PG8_BAR; PG8_SCHED;
            PG8_LDB(B1, 1, 1); PG8_STAGE(PG8_SB(1, 0), b3, voffB);
            PG8_BAR; PG8_WAIT_L(0); PG8_MMA(0, 1, At, B1); PG8_BAR;
            PG8_LDA(At, 1, 1); PG8_STAGE(PG8_SA(1, 0), a3, voffA);
            PG8_BAR; PG8_WAIT_L(0); PG8_MMA(1, 0, At, B0); PG8_BAR; PG8_SCHED;
            PG8_STAGE(PG8_SB(1, 1), b3 + hstep, voffB);
            PG8_WAIT_V(6); PG8_BAR; PG8_MMA(1, 1, At, B1); PG8_BAR;
            }
        }
        if constexpr (ALIGN_EPI) { if (wr == 0) PG8_BAR; }
        if constexpr (!Epi::AFTER_DRAIN) { E(acc, cur, wr, wc, fr, fq); S.done(cur); }
        if (!has_next) break;
#pragma unroll
        for (int a = 0; a < 2; ++a)
#pragma unroll
            for (int b = 0; b < 2; ++b)
#pragma unroll
                for (int m = 0; m < 4; ++m)
#pragma unroll
                    for (int n = 0; n < 2; ++n) acc[a][b][m][n] = (f32x4){0.f, 0.f, 0.f, 0.f};
        cur = nxt; cA = nA; cB = nB; ++ui;
        if constexpr (ALIGN_EPI) { if (wr == 1) PG8_BAR; }
    }
    PG8_WAIT_V(0);
    if constexpr (!ALIGN_EPI) { if (wr == 0) PG8_BAR; }
    PG8_BAR;
    if constexpr (Epi::AFTER_DRAIN) { E.fused(acc, cur, wr, wc, fr, fq, lds, wid, lane); S.done(cur); }
#undef PG8_SA
#undef PG8_SB
#undef PG8_STAGE
#undef PG8_LDA
#undef PG8_LDB
#undef PG8_MMA
#undef PG8_WAIT_V
#undef PG8_WAIT_L
#undef PG8_BAR
#undef PG8_SCHED
}
}

#define GAS __attribute__((address_space(1)))
#define LAS __attribute__((address_space(3)))
typedef unsigned short bf16;
typedef unsigned v4u __attribute__((ext_vector_type(4)));
typedef float f32x4 __attribute__((ext_vector_type(4)));
typedef short bf16x8 __attribute__((ext_vector_type(8)));
typedef GAS unsigned gu32;
typedef GAS unsigned long long gu64;
#define RLX_AGENT __ATOMIC_RELAXED, __HIP_MEMORY_SCOPE_AGENT
#define LDS_WAIT() asm volatile("s_waitcnt lgkmcnt(0)" ::: "memory")
#define VM_WAIT() asm volatile("s_waitcnt vmcnt(0)" ::: "memory")
__device__ __forceinline__ unsigned long long rt() { return __builtin_amdgcn_s_memrealtime(); }
__device__ __forceinline__ unsigned f2bf(float f) { unsigned u = __builtin_bit_cast(unsigned, f); return (u + 0x7fffu + ((u >> 16) & 1u)) >> 16; }
__device__ __forceinline__ unsigned pk2(float lo, float hi) { return f2bf(lo) | (f2bf(hi) << 16); }

#define XB_TMO      128
#define XB_XCNT(j)  (256  + 64 * (j))
#define XB_XSUB(j)  (1280 + 64 * (j))
#define XB_XGEN(j)  (2304 + 64 * (j))
#define XB_TOP      3328
#define XB_TOPGEN   3392
#define XCD_BAR_WORDS 3456
#define XB_SPIN_CAP (1u << 18)

__device__ __forceinline__ unsigned xb_ld(unsigned* p)              { return __hip_atomic_load(p, __ATOMIC_RELAXED, __HIP_MEMORY_SCOPE_AGENT); }
__device__ __forceinline__ unsigned xb_add(unsigned* p, unsigned v) { return __hip_atomic_fetch_add(p, v, __ATOMIC_RELAXED, __HIP_MEMORY_SCOPE_AGENT); }
__device__ __forceinline__ unsigned xb_xcc_id() { return (unsigned)__builtin_amdgcn_s_getreg((3 << 11) | 20) & 0xFu; }
#define XB_SPIN(cond, bar) do { unsigned _sp = 0; while (cond) { __builtin_amdgcn_s_sleep(1); \
    if ((++_sp & 255u) == 0u) { if (xb_ld(&(bar)[XB_TMO])) break; if (_sp > XB_SPIN_CAP) { atomicAdd(&(bar)[XB_TMO], 1u); break; } } } } while (0)

struct XcdBarrier {
    unsigned* bar; unsigned x;
    volatile LAS unsigned* st;
};

__device__ __forceinline__ XcdBarrier xcd_barrier_post(unsigned* bar, volatile LAS unsigned* st) {
    XcdBarrier b; b.bar = bar; b.x = xb_xcc_id(); b.st = st;
    if (threadIdx.x == 0) (void)xb_add(&bar[XB_XCNT(b.x)], 1u);
    return b;
}
__device__ __forceinline__ void xcd_barrier_complete(unsigned* bar, unsigned x, unsigned& nloc, unsigned& nx) {
    const unsigned G = gridDim.x * gridDim.y * gridDim.z;
    unsigned sum, cnt, mine, sp = 0u;
    for (;;) {
        sum = 0u; cnt = 0u; mine = 0u;
#pragma unroll
        for (unsigned j = 0; j < 16; ++j) { const unsigned c = xb_ld(&bar[XB_XCNT(j)]); sum += c; cnt += (c > 0u) ? 1u : 0u; mine = (j == x) ? c : mine; }
        if (sum == G) break;
        __builtin_amdgcn_s_sleep(1);
        if ((++sp & 255u) == 0u) { if (xb_ld(&bar[XB_TMO])) break; if (sp > XB_SPIN_CAP) { atomicAdd(&bar[XB_TMO], 1u); break; } }
    }
    nloc = mine > 0u ? mine : 1u; nx = cnt > 0u ? cnt : 1u;
}

__device__ __forceinline__ void xcd_barrier(const XcdBarrier& b) {
    asm volatile("s_waitcnt vmcnt(0)" ::: "memory");
    __syncthreads();
    if (threadIdx.x == 0) {
        unsigned* bar = b.bar;
        __builtin_amdgcn_s_waitcnt(0);
        unsigned nloc = b.st[0], nx = b.st[1];
        if (nloc == 0u) { xcd_barrier_complete(bar, b.x, nloc, nx); b.st[0] = nloc; b.st[1] = nx; }
        const unsigned old = xb_add(&bar[XB_XSUB(b.x)], 1u);
        const unsigned gen = old / nloc;
        if (old + 1u == (gen + 1u) * nloc) {
            __builtin_amdgcn_fence(__ATOMIC_RELEASE, "agent");
            asm volatile("s_waitcnt vmcnt(0)" ::: "memory");
            const unsigned og = xb_add(&bar[XB_TOP], 1u);
            const unsigned tg = og / nx;
            if (og + 1u == (tg + 1u) * nx) xb_add(&bar[XB_TOPGEN], 1u);
            else XB_SPIN(xb_ld(&bar[XB_TOPGEN]) == tg, bar);
            __builtin_amdgcn_fence(__ATOMIC_ACQUIRE, "agent");
            xb_add(&bar[XB_XGEN(b.x)], 1u);
            asm volatile("s_waitcnt vmcnt(0)" ::: "memory");
        } else {
            XB_SPIN(xb_ld(&bar[XB_XGEN(b.x)]) == gen, bar);
            __builtin_amdgcn_fence(__ATOMIC_ACQUIRE, "agent");
            asm volatile("s_waitcnt vmcnt(0)" ::: "memory");
        }
    }
    __syncthreads();
}


namespace mk {
using pg8::bf16_t; using pg8::bf16x8; using pg8::f32x4; using pg8::u32x4; using pg8::Unit;
typedef float f32x16 __attribute__((ext_vector_type(16)));
typedef float f32x2 __attribute__((ext_vector_type(2)));
typedef unsigned u32x2 __attribute__((ext_vector_type(2)));
typedef short s16x4 __attribute__((ext_vector_type(4)));
typedef short v4i16_t __attribute__((ext_vector_type(4)));
#define LDSP __attribute__((address_space(3)))
#define MFMA32(a, b, c) __builtin_amdgcn_mfma_f32_32x32x16_bf16((a), (b), (c), 0, 0, 0)

constexpr int D = 1024, TP = 16384, TS = 512, T = TP + TS, SEQ = 2048, FF = 4096;
constexpr int NBP = 2120, NBPAD = 2304, NPOOL = 2560;
constexpr float EPS = 1e-6f;
constexpr float IDXS = 0.04419417382415922f;
constexpr float QSCALE = 0.08838834764831845f * 1.4426950408889634f;
constexpr int KTOP = 256;

constexpr size_t MiB = 1u << 20;
constexpr size_t WS_CTL = 0, CTL_ZERO_BYTES = MiB;
constexpr size_t WS_ROPEA = 1 * MiB, WS_ROPEI = 1 * MiB + 512 * 1024;
constexpr size_t WS_SSQ = 2 * MiB;
constexpr size_t WS_WAIN = 4 * MiB, WS_WAOUT = 12 * MiB, WS_WBIN = 16 * MiB, WS_WBOUT = 26 * MiB, WS_W1 = 30 * MiB, WS_W2 = 62 * MiB;
constexpr size_t WS_X = 94 * MiB, WS_XB = 160 * MiB, WS_ACT = 194 * MiB, WS_END = 326 * MiB;
constexpr size_t A_UB = 0, A_VB = 33 * MiB, A_UM = 66 * MiB;
constexpr size_t B_Q = 0, B_KB = 33 * MiB, B_VB = 42 * MiB, B_QI = 51 * MiB, B_KI = 68 * MiB, B_WI = 71 * MiB, B_O = 72 * MiB;
constexpr int CW_BAR = 4096;
constexpr size_t O_Y = 0, O_NKP = 17301504, O_NVP = 25690112, O_NKIP = 34078720, O_NKS = 36175872, O_NVS = 36438016, O_NKIS = 36700160, O_CVP = 36765696, O_CVS = 38862848, O_END = 39911424;
constexpr int R0_BYTES = 141312;
constexpr int MASK_OFF = R0_BYTES, MASK_STRIDE = 34;
constexpr int MISC_OFF = MASK_OFF + 32 * MASK_STRIDE * 8;
constexpr int LDS_BYTES = 152576;
static_assert(MISC_OFF + 2048 <= LDS_BYTES, "LDS map");
constexpr int SCS = 2112;

__device__ __forceinline__ unsigned pk_bf16(float lo, float hi) {
    typedef float f2_t __attribute__((ext_vector_type(2))); typedef __bf16 b2_t __attribute__((ext_vector_type(2)));
    f2_t v = {lo, hi}; b2_t b = __builtin_convertvector(v, b2_t); return __builtin_bit_cast(unsigned, b);
}
__device__ __forceinline__ float bf_lo(unsigned w) { return __uint_as_float(w << 16); }
__device__ __forceinline__ float bf_hi(unsigned w) { return __uint_as_float(w & 0xffff0000u); }
__device__ __forceinline__ float wsum(float v) {
#pragma unroll
    for (int o = 1; o < 64; o <<= 1) v += __shfl_xor(v, o);
    return v;
}
__device__ __forceinline__ int wsum_i(int v) {
#pragma unroll
    for (int o = 1; o < 64; o <<= 1) v += __shfl_xor(v, o);
    return v;
}
__device__ __forceinline__ float wmax_f(float v) {
#pragma unroll
    for (int o = 1; o < 64; o <<= 1) v = fmaxf(v, __shfl_xor(v, o));
    return v;
}
__device__ __forceinline__ unsigned wmax_u(unsigned v) {
#pragma unroll
    for (int o = 1; o < 64; o <<= 1) { const unsigned t = (unsigned)__shfl_xor((int)v, o); v = t > v ? t : v; }
    return v;
}
__device__ __forceinline__ unsigned wmin_u(unsigned v) {
#pragma unroll
    for (int o = 1; o < 64; o <<= 1) { const unsigned t = (unsigned)__shfl_xor((int)v, o); v = t < v ? t : v; }
    return v;
}
__device__ __forceinline__ unsigned fkey(float s) { s = s + 0.0f; const unsigned u = __float_as_uint(s); return (u & 0x80000000u) ? ~u : (u | 0x80000000u); }
__device__ __forceinline__ float unkey(unsigned k) { return __uint_as_float((k & 0x80000000u) ? (k ^ 0x80000000u) : ~k); }
__device__ __forceinline__ float rscale(const float* ssq, int row, int fq) {
    const f32x4 p = *(const f32x4*)(ssq + (size_t)row * 16 + 4 * fq);
    float s = (p[0] + p[1]) + (p[2] + p[3]);
    s += __shfl_xor(s, 16); s += __shfl_xor(s, 32);
    return rsqrtf(s * (1.0f / 1024.0f) + EPS);
}
__device__ __forceinline__ float gelu_t(float x) {
    const float y = x * (0.7978845608f + 0.0356774081f * x * x);
    const float e = __builtin_amdgcn_exp2f(-2.885390082f * y);
    return x * __builtin_amdgcn_rcpf(1.0f + e);
}
__device__ __forceinline__ void st_bf16x4(bf16_t* p, const f32x4 v) { u32x2 w; w.x = pk_bf16(v[0], v[1]); w.y = pk_bf16(v[2], v[3]); *(u32x2*)p = w; }
__device__ __forceinline__ s16x4 vtr(const LDSP unsigned char* p) { return __builtin_bit_cast(s16x4, __builtin_amdgcn_ds_read_tr16_b64_v4i16((LDSP v4i16_t*)p)); }
__device__ __forceinline__ bf16x8 cat4(const s16x4 a, const s16x4 b) { return (bf16x8){a[0], a[1], a[2], a[3], b[0], b[1], b[2], b[3]}; }
__device__ __forceinline__ bf16x8 pack8(float a0, float a1, float a2, float a3, float a4, float a5, float a6, float a7) {
    u32x4 w; w.x = pk_bf16(a0, a1); w.y = pk_bf16(a2, a3); w.z = pk_bf16(a4, a5); w.w = pk_bf16(a6, a7); return __builtin_bit_cast(bf16x8, w);
}

__device__ __forceinline__ int fresh_lane() { int l; asm volatile("v_mbcnt_lo_u32_b32 %0, -1, 0\n\tv_mbcnt_hi_u32_b32 %0, -1, %0" : "=v"(l)); return l; }
struct EpiA1 {
    static constexpr bool PERM = false, AFTER_DRAIN = false;
    const float* ssq; bf16_t* ub; bf16_t* vb;
    __device__ __forceinline__ void operator()(const f32x4 (&acc)[2][2][4][2], const Unit& u, int wr, int wc, int fr, int fq) const {
        bf16_t* base = (u.pn < 4 ? ub : vb) + (u.pn & 3) * 256 + wc * 32 + 4 * fq;
        const int row0 = u.pm * 256 + wr * 64 + fr;
#pragma unroll
        for (int ai = 0; ai < 2; ++ai)
#pragma unroll
            for (int m = 0; m < 4; ++m) {
                const int row = row0 + ai * 128 + m * 16; const float r = rscale(ssq, row, fq);
                bf16_t* rp = base + (size_t)row * 1024;
#pragma unroll
                for (int bj = 0; bj < 2; ++bj)
#pragma unroll
                    for (int n = 0; n < 2; ++n) { f32x4 v = acc[ai][bj][m][n] * r;
                        v[0] = gelu_t(v[0]); v[1] = gelu_t(v[1]); v[2] = gelu_t(v[2]); v[3] = gelu_t(v[3]);
                        st_bf16x4(rp + bj * 128 + n * 16, v); }
            }
    }
};
struct EpiF1 {
    static constexpr bool PERM = false, AFTER_DRAIN = false;
    const float* ssq; bf16_t* a;
    __device__ __forceinline__ void operator()(const f32x4 (&acc)[2][2][4][2], const Unit& u, int wr, int wc, int fr, int fq) const {
        bf16_t* base = a + u.pn * 256 + wc * 32 + 4 * fq;
        const int row0 = u.pm * 256 + wr * 64 + fr;
#pragma unroll
        for (int ai = 0; ai < 2; ++ai)
#pragma unroll
            for (int m = 0; m < 4; ++m) {
                const int row = row0 + ai * 128 + m * 16; const float r = rscale(ssq, row, fq);
                bf16_t* rp = base + (size_t)row * FF;
#pragma unroll
                for (int bj = 0; bj < 2; ++bj)
#pragma unroll
                    for (int n = 0; n < 2; ++n) { f32x4 v = acc[ai][bj][m][n] * r;
#pragma unroll
                        for (int j = 0; j < 4; ++j) { const float t = fmaxf(v[j], 0.f); v[j] = t * t; }
                        st_bf16x4(rp + bj * 128 + n * 16, v); }
            }
    }
};
struct EpiRes {
    static constexpr bool PERM = false, AFTER_DRAIN = false;
    float* X; bf16_t* xb; float* ssq;
    __device__ __forceinline__ void operator()(const f32x4 (&acc)[2][2][4][2], const Unit& u, int wr, int wc, int fr, int fq) const {
        const int col0 = u.pn * 256 + wc * 32 + 4 * fq;
        const int row0 = u.pm * 256 + wr * 64 + fr;
#pragma unroll
        for (int ai = 0; ai < 2; ++ai)
#pragma unroll
            for (int m = 0; m < 4; ++m) {
                const int row = row0 + ai * 128 + m * 16; float q = 0.f;
                float* xr = X + (size_t)row * 1024 + col0; bf16_t* br = xb + (size_t)row * 1024 + col0;
#pragma unroll
                for (int bj = 0; bj < 2; ++bj)
#pragma unroll
                    for (int n = 0; n < 2; ++n) { const int o = bj * 128 + n * 16;
                        const f32x4 xn = *(const f32x4*)(xr + o) + acc[ai][bj][m][n];
                        *(f32x4*)(xr + o) = xn; st_bf16x4(br + o, xn);
                        q += (xn[0] * xn[0] + xn[1] * xn[1]) + (xn[2] * xn[2] + xn[3] * xn[3]); }
                q += __shfl_xor(q, 16); q += __shfl_xor(q, 32);
                if (fq == 0) ssq[(size_t)row * 16 + u.pn * 4 + wc] = q;
            }
    }
};
__device__ __forceinline__ void rope_pair(f32x4& v0, f32x4& v1, const f32x4 ca, const f32x4 cb) {
#pragma unroll
    for (int j = 0; j < 4; ++j) { const float c = (j < 2 ? ca : cb)[2 * (j & 1)], s = (j < 2 ? ca : cb)[2 * (j & 1) + 1];
        const float x1 = v0[j], x2 = v1[j]; v0[j] = x1 * c - x2 * s; v1[j] = x2 * c + x1 * s; }
}
__device__ __forceinline__ void rope_idx(f32x4& v0, const float* ropeI, int pos, int fq) {
    const float* cp = ropeI + ((size_t)pos * 8 + 4 * (fq & 1)) * 2;
    const f32x4 ca = *(const f32x4*)cp, cb = *(const f32x4*)(cp + 4);
#pragma unroll
    for (int j = 0; j < 4; ++j) { const float c = (j < 2 ? ca : cb)[2 * (j & 1)], s = (j < 2 ? ca : cb)[2 * (j & 1) + 1];
        const float own = v0[j], oth = __shfl_xor(own, 32);
        v0[j] = (fq < 2) ? own * c - oth * s : own * c + oth * s; }
}
struct EpiB1 {
    static constexpr bool PERM = false, AFTER_DRAIN = false;
    unsigned char* ws; float* out; int jB;
    __device__ __forceinline__ void operator()(const f32x4 (&acc)[2][2][4][2], const Unit& u, int wr, int wc, int fr, int fq) const {
        const int pn = u.pn; const bool samp = u.pm >= 64;
        const int row0 = u.pm * 256 + wr * 64 + fr;
        const float* ssq = (const float*)(ws + WS_SSQ); const float* ropeA = (const float*)(ws + WS_ROPEA); const float* ropeI = (const float*)(ws + WS_ROPEI);
        bf16_t* Q = (bf16_t*)(ws + WS_ACT + B_Q); bf16_t* QI = (bf16_t*)(ws + WS_ACT + B_QI); bf16_t* KI = (bf16_t*)(ws + WS_ACT + B_KI); float* WI = (float*)(ws + WS_ACT + B_WI);
        if (pn < 4) {
#pragma unroll
            for (int ai = 0; ai < 2; ++ai)
#pragma unroll
                for (int m = 0; m < 4; ++m) {
                    const int row = row0 + ai * 128 + m * 16; const float r = rscale(ssq, row, fq) * QSCALE;
                    const int pos = samp ? SEQ + (row & 3) : (row & (SEQ - 1));
                    f32x4 ca = {0.f, 0.f, 0.f, 0.f}, cb = ca;
                    if (wc == 0) { const float* cp = ropeA + ((size_t)pos * 16 + 4 * fq) * 2; ca = *(const f32x4*)cp; cb = *(const f32x4*)(cp + 4); }
                    bf16_t* rp = Q + (size_t)row * 1024 + pn * 256 + wc * 32 + 4 * fq;
#pragma unroll
                    for (int bj = 0; bj < 2; ++bj) { f32x4 v0 = acc[ai][bj][m][0] * r, v1 = acc[ai][bj][m][1] * r;
                        if (wc == 0) rope_pair(v0, v1, ca, cb);
                        st_bf16x4(rp + bj * 128, v0); st_bf16x4(rp + bj * 128 + 16, v1); }
                }
        } else if (pn == 4 || pn == 5) {
            const size_t ofs = (pn == 4) ? (samp ? O_NKS + (size_t)jB * TS * 256 : O_NKP + (size_t)jB * TP * 256) : (samp ? O_NVS + (size_t)jB * TS * 256 : O_NVP + (size_t)jB * TP * 256);
            float* of = out + ofs;
            bf16_t* ob = (bf16_t*)(ws + WS_ACT + ((pn == 4) ? B_KB : B_VB));
#pragma unroll
            for (int ai = 0; ai < 2; ++ai)
#pragma unroll
                for (int m = 0; m < 4; ++m) {
                    const int row = row0 + ai * 128 + m * 16; const float r = rscale(ssq, row, fq);
                    const int pos = samp ? SEQ + (row & 3) : (row & (SEQ - 1)); const int rowo = samp ? row - TP : row;
                    f32x4 ca = {0.f, 0.f, 0.f, 0.f}, cb = ca;
                    const bool rot = (pn == 4) && (wc == 0);
                    if (rot) { const float* cp = ropeA + ((size_t)pos * 16 + 4 * fq) * 2; ca = *(const f32x4*)cp; cb = *(const f32x4*)(cp + 4); }
                    float* fp = of + (size_t)rowo * 256 + wc * 32 + 4 * fq; bf16_t* bp = ob + (size_t)row * 256 + wc * 32 + 4 * fq;
#pragma unroll
                    for (int bj = 0; bj < 2; ++bj) { f32x4 v0 = acc[ai][bj][m][0] * r, v1 = acc[ai][bj][m][1] * r;
                        if (rot) rope_pair(v0, v1, ca, cb);
                        *(f32x4*)(fp + bj * 128) = v0; *(f32x4*)(fp + bj * 128 + 16) = v1;
                        st_bf16x4(bp + bj * 128, v0); st_bf16x4(bp + bj * 128 + 16, v1); }
                }
        } else if (pn < 8) {
#pragma unroll
            for (int ai = 0; ai < 2; ++ai)
#pragma unroll
                for (int m = 0; m < 4; ++m) {
                    const int row = row0 + ai * 128 + m * 16; const float r = rscale(ssq, row, fq);
                    const int pos = samp ? SEQ + (row & 3) : (row & (SEQ - 1));
                    bf16_t* rp = QI + (size_t)row * 512 + (pn - 6) * 256 + wc * 32 + 4 * fq;
#pragma unroll
                    for (int bj = 0; bj < 2; ++bj) { f32x4 v0 = acc[ai][bj][m][0] * r, v1 = acc[ai][bj][m][1] * r;
                        if ((wc & 1) == 0) rope_idx(v0, ropeI, pos, fq);
                        st_bf16x4(rp + bj * 128, v0); st_bf16x4(rp + bj * 128 + 16, v1); }
                }
        } else {
            float* of = out + (samp ? O_NKIS + (size_t)jB * TS * 64 : O_NKIP + (size_t)jB * TP * 64);
#pragma unroll
            for (int ai = 0; ai < 2; ++ai)
#pragma unroll
                for (int m = 0; m < 4; ++m) {
                    const int row = row0 + ai * 128 + m * 16; const float r = rscale(ssq, row, fq);
                    const int pos = samp ? SEQ + (row & 3) : (row & (SEQ - 1)); const int rowo = samp ? row - TP : row;
                    f32x4 v0 = acc[ai][0][m][0] * r, v1 = acc[ai][0][m][1] * r;
                    if (wc < 2) {
                        if (wc == 0) rope_idx(v0, ropeI, pos, fq);
                        float* fp = of + (size_t)rowo * 64 + wc * 32 + 4 * fq; bf16_t* bp = KI + (size_t)row * 64 + wc * 32 + 4 * fq;
                        *(f32x4*)fp = v0; *(f32x4*)(fp + 16) = v1; st_bf16x4(bp, v0); st_bf16x4(bp + 16, v1);
                    } else if (wc == 2) {
                        if (fq < 2) *(f32x4*)(WI + (size_t)row * 8 + 4 * fq) = v0;
                    }
                }
        }
    }
};

__device__ __forceinline__ void transpose_item(const float* W, const float* gain, int K, int N, bf16_t* WT, LDSP float* scr, int item, int nblk, int lane) {
    const int kb = item / nblk, nb = item % nblk, k0 = 64 * kb, n0 = 32 * nb;
    const int nn = n0 + (lane & 31); const bool inb = nn < N;
#pragma unroll 8
    for (int i = 0; i < 32; ++i) { const int kk = 2 * i + (lane >> 5);
        float w = inb ? W[(size_t)(k0 + kk) * N + nn] : 0.f; if (gain) w *= gain[k0 + kk];
        scr[kk * 33 + (lane & 31)] = w; }
    asm volatile("s_waitcnt lgkmcnt(0)" ::: "memory");
    const int c = lane & 7;
#pragma unroll
    for (int j = 0; j < 4; ++j) { const int n = (lane >> 3) + 8 * j; const LDSP float* s = scr + (8 * c) * 33 + n;
        u32x4 o; o.x = pk_bf16(s[0 * 33], s[1 * 33]); o.y = pk_bf16(s[2 * 33], s[3 * 33]); o.z = pk_bf16(s[4 * 33], s[5 * 33]); o.w = pk_bf16(s[6 * 33], s[7 * 33]);
        *(u32x4*)(WT + (size_t)(n0 + n) * K + k0 + 8 * c) = o; }
    asm volatile("s_waitcnt lgkmcnt(0)" ::: "memory");
}

struct Ptrs {
    const float *xp, *xs, *cache_k, *cache_v, *cache_kidx; const int* page_table;
    const float *norm_mix, *norm_ffn, *a_w_in, *a_v_gain, *a_w_s, *a_b_s, *a_w_out, *b_w_in, *b_w_out, *ffn_w1, *ffn_w2, *norm_final;
    float* out; unsigned char* ws;
};

__device__ __forceinline__ void prologue(const Ptrs& P, LDSP unsigned char* lds, float myinv  , int gw, int NGW, int wid, int lane) {
    LDSP float* scr = (LDSP float*)(lds + wid * 16384);
    constexpr int I_AIN = 16 * 64, I_AOUT = 16 * 32, I_BIN = 16 * 72, I_BOUT = 16 * 32, I_W1 = 16 * 128, I_W2 = 64 * 32;
    constexpr int NITEMS = 2 * (I_AIN + I_AOUT + I_BIN + I_BOUT) + 4 * (I_W1 + I_W2);
    bf16_t* ws_ain = (bf16_t*)(P.ws + WS_WAIN); bf16_t* ws_aout = (bf16_t*)(P.ws + WS_WAOUT); bf16_t* ws_bin = (bf16_t*)(P.ws + WS_WBIN);
    bf16_t* ws_bout = (bf16_t*)(P.ws + WS_WBOUT); bf16_t* ws_w1 = (bf16_t*)(P.ws + WS_W1); bf16_t* ws_w2 = (bf16_t*)(P.ws + WS_W2);
    for (int it = gw; it < NITEMS; it += NGW) {
        int r = it;
        if (r < 2 * I_AIN) { const int j = r / I_AIN; r -= j * I_AIN;
            transpose_item(P.a_w_in + (size_t)j * D * 2048, P.norm_mix + (2 * j) * D, D, 2048, ws_ain + (size_t)j * 2048 * D, scr, r, 64, lane); continue; }
        r -= 2 * I_AIN;
        if (r < 2 * I_AOUT) { const int j = r / I_AOUT; r -= j * I_AOUT;
            transpose_item(P.a_w_out + (size_t)j * D * D, nullptr, D, D, ws_aout + (size_t)j * D * D, scr, r, 32, lane); continue; }
        r -= 2 * I_AOUT;
        if (r < 2 * I_BIN) { const int j = r / I_BIN; r -= j * I_BIN;
            transpose_item(P.b_w_in + (size_t)j * D * NBP, P.norm_mix + (2 * j + 1) * D, D, NBP, ws_bin + (size_t)j * NBPAD * D, scr, r, 72, lane); continue; }
        r -= 2 * I_BIN;
        if (r < 2 * I_BOUT) { const int j = r / I_BOUT; r -= j * I_BOUT;
            transpose_item(P.b_w_out + (size_t)j * D * D, nullptr, D, D, ws_bout + (size_t)j * D * D, scr, r, 32, lane); continue; }
        r -= 2 * I_BOUT;
        if (r < 4 * I_W1) { const int i = r / I_W1; r -= i * I_W1;
            transpose_item(P.ffn_w1 + (size_t)i * D * FF, P.norm_ffn + i * D, D, FF, ws_w1 + (size_t)i * FF * D, scr, r, 128, lane); continue; }
        r -= 4 * I_W1;
        { const int i = r / I_W2; r -= i * I_W2;
            transpose_item(P.ffn_w2 + (size_t)i * FF * D, nullptr, FF, D, ws_w2 + (size_t)i * D * FF, scr, r, 32, lane); }
    }
    float* X = (float*)(P.ws + WS_X); bf16_t* xb = (bf16_t*)(P.ws + WS_XB); float* ssq = (float*)(P.ws + WS_SSQ);
    for (int m = gw; m < T; m += NGW) {
        const float* src = (m < TP) ? P.xp + (size_t)m * D : P.xs + (size_t)(m - TP) * D;
#pragma unroll
        for (int j = 0; j < 4; ++j) {
            const f32x4 v = *(const f32x4*)(src + 256 * j + 4 * lane);
            *(f32x4*)(X + (size_t)m * D + 256 * j + 4 * lane) = v;
            st_bf16x4(xb + (size_t)m * D + 256 * j + 4 * lane, v);
            float q = (v[0] * v[0] + v[1] * v[1]) + (v[2] * v[2] + v[3] * v[3]);
            q += __shfl_xor(q, 1); q += __shfl_xor(q, 2); q += __shfl_xor(q, 4); q += __shfl_xor(q, 8);
            if ((lane & 15) == 0) ssq[(size_t)m * 16 + 4 * j + (lane >> 4)] = q;
        }
    }
    float* ropeA = (float*)(P.ws + WS_ROPEA); float* ropeI = (float*)(P.ws + WS_ROPEI);
    const int gt = gw * 64 + lane, NGT = NGW * 64;
    for (int e = gt; e < 2052 * 24; e += NGT) {
        const int pos = e / 24, i = e % 24;
        const float inv = __shfl(myinv, i);
        const float ang = (float)pos * inv;
        const double a = (double)ang; const double k = rint(a * 0.15915494309189535); const double rr = fma(-k, 6.283185307179586, a);
        const float rf = (float)rr; const float c = cosf(rf), s = sinf(rf);
        float* dst = (i < 16) ? ropeA + ((size_t)pos * 16 + i) * 2 : ropeI + ((size_t)pos * 8 + (i - 16)) * 2;
        dst[0] = c; dst[1] = s;
    }
}

__device__ __forceinline__ void final_norm(const Ptrs& P, int gw, int NGW, int lane) {
    const float* X = (const float*)(P.ws + WS_X);
    for (int m = gw; m < T; m += NGW) {
        f32x4 v[4]; float q = 0.f;
#pragma unroll
        for (int j = 0; j < 4; ++j) { v[j] = *(const f32x4*)(X + (size_t)m * D + 256 * j + 4 * lane); q += (v[j][0] * v[j][0] + v[j][1] * v[j][1]) + (v[j][2] * v[j][2] + v[j][3] * v[j][3]); }
        const float r = rsqrtf(wsum(q) * (1.0f / 1024.0f) + EPS);
#pragma unroll
        for (int j = 0; j < 4; ++j) { const f32x4 g = *(const f32x4*)(P.norm_final + 256 * j + 4 * lane);
            *(f32x4*)(P.out + O_Y + (size_t)m * D + 256 * j + 4 * lane) = v[j] * r * g; }
    }
}

constexpr int MIX_VP = 320;
__device__ __forceinline__ void mix_prompt(const Ptrs& P, LDSP unsigned char* lds, int jA, int unit, int tid, int wid, int lane) {
    const int n = unit >> 5, c = (unit >> 1) & 15, hf = unit & 1; const int R0 = n * SEQ + c * 128;
    const bf16_t* ub = (const bf16_t*)(P.ws + WS_ACT + A_UB); const bf16_t* vb = (const bf16_t*)(P.ws + WS_ACT + A_VB); bf16_t* um = (bf16_t*)(P.ws + WS_ACT + A_UM);
    const float* gain = P.a_v_gain + jA * D; const float* wsm = P.a_w_s + (size_t)jA * 8 * 128 * 128; const float* bsm = P.a_b_s + jA * 8 * 128;
    LDSP float* st = (LDSP float*)(lds + 128 * MIX_VP);
    for (int rr = 0; rr < 16; ++rr) {
        const int s = 16 * wid + rr; const bf16_t* vr = vb + (size_t)(R0 + s) * 1024;
        const u32x4 a = *(const u32x4*)(vr + 8 * lane), b = *(const u32x4*)(vr + 512 + 8 * lane);
        float x[16];
#pragma unroll
        for (int k = 0; k < 4; ++k) { x[2 * k] = bf_lo(a[k]); x[2 * k + 1] = bf_hi(a[k]); x[8 + 2 * k] = bf_lo(b[k]); x[8 + 2 * k + 1] = bf_hi(b[k]); }
        float sm = 0.f;
#pragma unroll
        for (int k = 0; k < 16; ++k) sm += x[k];
        const float mu = wsum(sm) * (1.0f / 1024.0f); float sq = 0.f;
#pragma unroll
        for (int k = 0; k < 16; ++k) { const float d = x[k] - mu; sq += d * d; }
        const float rstd = rsqrtf(wsum(sq) * (1.0f / 1024.0f) + EPS);
        if (lane == 0) { st[s] = mu; st[128 + s] = rstd; }
        if (c == 15) {
            float* o = P.out + O_CVP + ((size_t)(jA * 8 + n) * 128 + s) * 1024 + 512 * hf + 8 * lane;
            const float* gp = gain + 512 * hf + 8 * lane; const f32x4 g0 = *(const f32x4*)gp, g1 = *(const f32x4*)(gp + 4);
            f32x4 o0, o1;
{ const u32x4 sv = hf ? b : a;
              o0[0] = (bf_lo(sv.x) - mu) * rstd * g0[0]; o0[1] = (bf_hi(sv.x) - mu) * rstd * g0[1]; o0[2] = (bf_lo(sv.y) - mu) * rstd * g0[2]; o0[3] = (bf_hi(sv.y) - mu) * rstd * g0[3];
              o1[0] = (bf_lo(sv.z) - mu) * rstd * g1[0]; o1[1] = (bf_hi(sv.z) - mu) * rstd * g1[1]; o1[2] = (bf_lo(sv.w) - mu) * rstd * g1[2]; o1[3] = (bf_hi(sv.w) - mu) * rstd * g1[3]; }
            *(f32x4*)o = o0; *(f32x4*)(o + 4) = o1;
        }
    }
    __syncthreads();
    const int l31 = lane & 31, hi = lane >> 5, i16 = lane & 15;
    const int tt = wid & 3, dh = wid >> 2;
    for (int gg = 0; gg < 4; ++gg) {
        const int g = 4 * hf + gg;
#pragma unroll
        for (int k = 0; k < 4; ++k) { const int id = tid + 512 * k, s = id >> 4, dc = id & 15;
            const u32x4 a = *(const u32x4*)(vb + (size_t)(R0 + s) * 1024 + g * 128 + dc * 8);
            const float mu = st[s], rstd = st[128 + s]; const float* gp = gain + g * 128 + dc * 8; const f32x4 g0 = *(const f32x4*)gp, g1 = *(const f32x4*)(gp + 4);
            u32x4 o;
            o.x = pk_bf16((bf_lo(a.x) - mu) * rstd * g0[0], (bf_hi(a.x) - mu) * rstd * g0[1]); o.y = pk_bf16((bf_lo(a.y) - mu) * rstd * g0[2], (bf_hi(a.y) - mu) * rstd * g0[3]);
            o.z = pk_bf16((bf_lo(a.z) - mu) * rstd * g1[0], (bf_hi(a.z) - mu) * rstd * g1[1]); o.w = pk_bf16((bf_lo(a.w) - mu) * rstd * g1[2], (bf_hi(a.w) - mu) * rstd * g1[3]);
            *(LDSP u32x4*)(lds + s * MIX_VP + dc * 16) = o; }
        __syncthreads();
        f32x16 acc0, acc1;
#pragma unroll
        for (int i = 0; i < 16; ++i) { acc0[i] = 0.f; acc1[i] = 0.f; }
        const int t = 32 * tt + l31; const float* wrow = wsm + ((size_t)g * 128 + t) * 128;
        const LDSP unsigned char* vp = lds + (size_t)(8 * hi + (i16 >> 2)) * MIX_VP + (64 * dh + 16 * ((lane >> 4) & 1) + 4 * (i16 & 3)) * 2;
        for (int ks = 0; ks < 2 * tt + 2; ++ks) {
            const int s0 = 16 * ks + 8 * hi; const f32x4 w0 = *(const f32x4*)(wrow + s0), w1 = *(const f32x4*)(wrow + s0 + 4);
            float w[8] = {w0[0], w0[1], w0[2], w0[3], w1[0], w1[1], w1[2], w1[3]};
#pragma unroll
            for (int e = 0; e < 8; ++e) if (s0 + e > t) w[e] = 0.f;
            const bf16x8 bfrag = pack8(w[0], w[1], w[2], w[3], w[4], w[5], w[6], w[7]);
            const LDSP unsigned char* vk = vp + (size_t)(16 * ks) * MIX_VP;
            const bf16x8 a0 = cat4(vtr(vk), vtr(vk + 4 * MIX_VP)), a1 = cat4(vtr(vk + 64), vtr(vk + 4 * MIX_VP + 64));
            acc0 = MFMA32(a0, bfrag, acc0); acc1 = MFMA32(a1, bfrag, acc1);
        }
        const float bias = bsm[g * 128 + t];
        const size_t ro = (size_t)(R0 + t) * 1024 + g * 128 + 64 * dh + 4 * hi;
#pragma unroll
        for (int dti = 0; dti < 2; ++dti)
#pragma unroll
            for (int qd = 0; qd < 4; ++qd) { const size_t o = ro + 32 * dti + 8 * qd;
                const u32x2 uu = *(const u32x2*)(ub + o); f32x4 r;
                const f32x16& A = dti ? acc1 : acc0;
                r[0] = bf_lo(uu.x) * (A[4 * qd] + bias); r[1] = bf_hi(uu.x) * (A[4 * qd + 1] + bias); r[2] = bf_lo(uu.y) * (A[4 * qd + 2] + bias); r[3] = bf_hi(uu.y) * (A[4 * qd + 3] + bias);
                st_bf16x4(um + o, r); }
        __syncthreads();
    }
}
__device__ __forceinline__ void mix_sample(const Ptrs& P, LDSP unsigned char* lds, int jA, int nb, int tid, int wid, int lane) {
    const int R0 = TP + 4 * nb;
    const bf16_t* ub = (const bf16_t*)(P.ws + WS_ACT + A_UB); const bf16_t* vb = (const bf16_t*)(P.ws + WS_ACT + A_VB); bf16_t* um = (bf16_t*)(P.ws + WS_ACT + A_UM);
    const float* gain = P.a_v_gain + jA * D; const float* wsm = P.a_w_s + (size_t)jA * 8 * 128 * 128; const float* bsm = P.a_b_s + jA * 8 * 128;
    LDSP float* st = (LDSP float*)lds;
    if (wid < 4) {
        const bf16_t* vr = vb + (size_t)(R0 + wid) * 1024;
        const u32x4 a = *(const u32x4*)(vr + 8 * lane), b = *(const u32x4*)(vr + 512 + 8 * lane);
        float x[16];
#pragma unroll
        for (int k = 0; k < 4; ++k) { x[2 * k] = bf_lo(a[k]); x[2 * k + 1] = bf_hi(a[k]); x[8 + 2 * k] = bf_lo(b[k]); x[8 + 2 * k + 1] = bf_hi(b[k]); }
        float sm = 0.f;
#pragma unroll
        for (int k = 0; k < 16; ++k) sm += x[k];
        const float mu = wsum(sm) * (1.0f / 1024.0f); float sq = 0.f;
#pragma unroll
        for (int k = 0; k < 16; ++k) { const float d = x[k] - mu; sq += d * d; }
        const float rstd = rsqrtf(wsum(sq) * (1.0f / 1024.0f) + EPS);
        if (lane == 0) { st[wid] = mu; st[4 + wid] = rstd; }
    }
    __syncthreads();
    const int col = 2 * tid, g = col >> 7;
    float vn[4][2];
#pragma unroll
    for (int s = 0; s < 4; ++s) { const unsigned w = *(const unsigned*)(vb + (size_t)(R0 + s) * 1024 + col); const float mu = st[s], rstd = st[4 + s];
        vn[s][0] = (bf_lo(w) - mu) * rstd * gain[col]; vn[s][1] = (bf_hi(w) - mu) * rstd * gain[col + 1];
        *(f32x2*)(P.out + O_CVS + ((size_t)(jA * 128 + nb) * 4 + s) * 1024 + col) = (f32x2){vn[s][0], vn[s][1]}; }
#pragma unroll
    for (int t = 0; t < 4; ++t) {
        float m0 = bsm[g * 128 + t], m1 = m0;
#pragma unroll
        for (int s = 0; s < 4; ++s) if (s <= t) { const float w = wsm[((size_t)g * 128 + t) * 128 + s]; m0 += w * vn[s][0]; m1 += w * vn[s][1]; }
        const unsigned uu = *(const unsigned*)(ub + (size_t)(R0 + t) * 1024 + col);
        *(unsigned*)(um + (size_t)(R0 + t) * 1024 + col) = pk_bf16(bf_lo(uu) * m0, bf_hi(uu) * m1);
    }
    __syncthreads();
}

__device__ __forceinline__ void index_prompt(LDSP unsigned* sc, const LDSP f32x4* wtab  , const bf16_t* QI, const bf16_t* KI, int rowbase, int qa, int nkt, int wid, int lane_unused) {
    const int lane = fresh_lane();
    const int rr = lane & 31, hi = lane >> 5, blk = rr >> 2;
    const int qit = (blk >> 2) + 2 * (blk & 1), head = 4 * ((blk >> 1) & 1) + (rr & 3);
    bf16x8 A[4][4];
#pragma unroll
    for (int rt = 0; rt < 4; ++rt) {
        const bf16_t* qp = QI + (size_t)(rowbase + qa + 4 * rt + qit) * 512 + head * 64 + 8 * hi;
#pragma unroll
        for (int ks = 0; ks < 4; ++ks) A[rt][ks] = *(const bf16x8*)(qp + 16 * ks);
    }
    const LDSP f32x4* wl = wtab + 4 * hi;
    for (int kt = wid; kt < nkt; kt += 8) {
        const int key = 32 * kt + rr; const bf16_t* kp = KI + (size_t)(rowbase + key) * 64 + 8 * hi;
        bf16x8 B[4];
#pragma unroll
        for (int ks = 0; ks < 4; ++ks) B[ks] = *(const bf16x8*)(kp + 16 * ks);
#pragma unroll
        for (int rt = 0; rt < 4; ++rt) {
            f32x16 acc;
#pragma unroll
            for (int i = 0; i < 16; ++i) acc[i] = 0.f;
#pragma unroll
            for (int ks = 0; ks < 4; ++ks) acc = MFMA32(A[rt][ks], B[ks], acc);
            float s0 = 0.f, s1 = 0.f;
            const f32x4 wa = wl[8 * rt], wb = wl[8 * rt + 1], wc4 = wl[8 * rt + 2], wd = wl[8 * rt + 3];
#pragma unroll
            for (int h = 0; h < 4; ++h) { s0 = fmaf(wa[h], fmaxf(acc[h], 0.f), s0); s1 = fmaf(wc4[h], fmaxf(acc[8 + h], 0.f), s1); }
#pragma unroll
            for (int h = 0; h < 4; ++h) { s0 = fmaf(wb[h], fmaxf(acc[4 + h], 0.f), s0); s1 = fmaf(wd[h], fmaxf(acc[12 + h], 0.f), s1); }
            const int ql = 4 * rt + 2 * hi;
            sc[ql * SCS + key] = (key <= qa + ql) ? fkey(s0) : 0u;
            sc[(ql + 1) * SCS + key] = (key <= qa + ql + 1) ? fkey(s1) : 0u;
        }
    }
}
__device__ __forceinline__ void index_sample(LDSP unsigned* sc, const bf16_t* QI, const float* WI, const bf16_t* KI, const float* ckidx  , const LDSP int* pt, int nd, int t0, int wid, int lane) {
    const int rr = lane & 31, hi = lane >> 5, blk = rr >> 2;
    const int qit = (blk >> 2) + 2 * (blk & 1), head = 4 * ((blk >> 1) & 1) + (rr & 3);
    const int qrow = TP + 4 * nd + t0;
    bf16x8 A[4]; float wgt[16];
    const bf16x8 zero8 = {0, 0, 0, 0, 0, 0, 0, 0};
#pragma unroll
    for (int ks = 0; ks < 4; ++ks) A[ks] = (qit < 2) ? *(const bf16x8*)(QI + (size_t)(qrow + (qit & 1)) * 512 + head * 64 + 16 * ks + 8 * hi) : zero8;
#pragma unroll
    for (int qq = 0; qq < 2; ++qq) { const float* wp = WI + (size_t)(qrow + qq) * 8; const f32x4 w0 = *(const f32x4*)wp, w1 = *(const f32x4*)(wp + 4);
#pragma unroll
        for (int h = 0; h < 4; ++h) { wgt[8 * qq + h] = hi ? 0.f : w0[h] * IDXS; wgt[8 * qq + 4 + h] = hi ? 0.f : w1[h] * IDXS; } }
    for (int kt = wid; kt < 65; kt += 8) {
        bf16x8 B[4];
        if (kt < 64) {
            const int page = pt[kt >> 2]; const float* kp = ckidx + ((size_t)page * 128 + (kt & 3) * 32 + rr) * 64 + 8 * hi;
#pragma unroll
            for (int ks = 0; ks < 4; ++ks) { const f32x4 a = *(const f32x4*)(kp + 16 * ks), b = *(const f32x4*)(kp + 16 * ks + 4); B[ks] = pack8(a[0], a[1], a[2], a[3], b[0], b[1], b[2], b[3]); }
        } else {
#pragma unroll
            for (int ks = 0; ks < 4; ++ks) B[ks] = (rr < 4) ? *(const bf16x8*)(KI + (size_t)(TP + 4 * nd + rr) * 64 + 16 * ks + 8 * hi) : zero8;
        }
        f32x16 acc;
#pragma unroll
        for (int i = 0; i < 16; ++i) acc[i] = 0.f;
#pragma unroll
        for (int ks = 0; ks < 4; ++ks) acc = MFMA32(A[ks], B[ks], acc);
        float s0 = 0.f, s1 = 0.f;
#pragma unroll
        for (int h = 0; h < 8; ++h) { s0 = fmaf(wgt[h], fmaxf(acc[h], 0.f), s0); s1 = fmaf(wgt[8 + h], fmaxf(acc[8 + h], 0.f), s1); }
        const int keypos = 32 * kt + rr;
        if (hi == 0) { sc[keypos] = (keypos <= SEQ + t0) ? fkey(s0) : 0u; sc[SCS + keypos] = (keypos <= SEQ + t0 + 1) ? fkey(s1) : 0u; }
    }
}
__device__ __forceinline__ void select_row(const LDSP unsigned* scrow, int nk, int nvalid, LDSP unsigned long long* maskrow, int lane_unused) {
    const int lane = fresh_lane();
    unsigned k[33];
#pragma unroll
    for (int r = 0; r < 33; ++r) { const int idx = 64 * r + lane; k[r] = (idx < nk) ? scrow[idx] : 0u; }
    unsigned Tgt = 0u, Teq = 0u; int need = 0;
    if (nvalid > KTOP) {
        unsigned kmax = 0u, kmin = 0xffffffffu;
#pragma unroll
        for (int r = 0; r < 33; ++r) { kmax = k[r] > kmax ? k[r] : kmax; const unsigned t = k[r] ? k[r] : 0xffffffffu; kmin = t < kmin ? t : kmin; }
        kmax = wmax_u(kmax); kmin = wmin_u(kmin);
        unsigned lo = kmin, hi = kmax + 1u; int flo = nvalid, fhi = 0;
        for (int it = 0; it < 200; ++it) {
            if (flo == KTOP || hi - lo <= 1u) break;
            unsigned mid;
            if ((it % 3) == 2) mid = lo + ((hi - lo) >> 1);
            else { const float lv = unkey(lo), hv = unkey(hi - 1u); const float frac = ((float)(flo - KTOP) + 0.5f) / (float)(flo - fhi); mid = fkey(lv + (hv - lv) * frac); }
            mid = mid > hi - 1u ? hi - 1u : mid; mid = mid < lo + 1u ? lo + 1u : mid;
            int c = 0;
#pragma unroll
            for (int r = 0; r < 33; ++r) c += (k[r] >= mid) ? 1 : 0;
            c = wsum_i(c);
            if (c >= KTOP) { lo = mid; flo = c; } else { hi = mid; fhi = c; }
        }
        if (flo == KTOP) { Tgt = lo - 1u; Teq = 0u; need = 0; } else { Tgt = lo; Teq = lo; need = KTOP - fhi; }
    }
    unsigned long long myw = 0ull;
#pragma unroll
    for (int r = 0; r < 33; ++r) {
        const bool gt = k[r] > Tgt; const bool eq = (need > 0) && (k[r] == Teq);
        const unsigned long long eb = __builtin_amdgcn_ballot_w64(eq);
        const int pre = (int)__builtin_amdgcn_mbcnt_hi((unsigned)(eb >> 32), __builtin_amdgcn_mbcnt_lo((unsigned)eb, 0u));
        const bool take = eq && (pre < need);
        const int ne = __builtin_popcountll(eb); need -= (ne < need ? ne : need);
        const unsigned long long bal = __builtin_amdgcn_ballot_w64(gt || take);
        if (lane == r) myw = bal;
    }
    if (lane < 33) maskrow[lane] = myw;
}

constexpr int AT_KP = 528, AT_VP = 576, AT_VOFF = 64 * AT_KP, AT_BUF = 64 * AT_KP + 64 * AT_VP;
static_assert(2 * AT_BUF <= R0_BYTES, "attention tiles fit region 0");
__device__ __forceinline__ void attn_qblock(LDSP unsigned char* lds, const LDSP unsigned long long* maskL, const bf16_t* Q, const bf16_t* KB, const bf16_t* VB, bf16_t* O,
                                            int rowbase, int q0, int ntile, int tid_unused, int wid, int lane_unused) {
    const int lane = fresh_lane();
    const int c = lane & 31, hi = lane >> 5, kvh = wid >> 2, posl = 8 * (wid & 3) + (c >> 2), g = c & 3, i16 = lane & 15;
    const size_t qrow = (size_t)(rowbase + q0 + posl);
    bf16x8 Qf[8];
#pragma unroll
    for (int ks = 0; ks < 8; ++ks) Qf[ks] = *(const bf16x8*)(Q + qrow * 1024 + (kvh * 4 + g) * 128 + 16 * ks + 8 * hi);
    f32x16 Oa[4];
#pragma unroll
    for (int dt = 0; dt < 4; ++dt)
#pragma unroll
        for (int i = 0; i < 16; ++i) Oa[dt][i] = 0.f;
    float m_run = -1e30f, l_run = 0.f;
    const bf16_t* kg = KB + (size_t)rowbase * 256 + (size_t)(8 * wid) * 256 + 8 * c; const bf16_t* vg = VB + (size_t)rowbase * 256 + (size_t)(8 * wid) * 256 + 8 * c;
#define AT_DMA(tile, buf) do { if (lane < 32) { _Pragma("unroll") for (int i_ = 0; i_ < 8; ++i_) { \
        __builtin_amdgcn_global_load_lds((const unsigned*)(kg + (size_t)(tile) * 64 * 256 + i_ * 256), (LDSP unsigned*)(lds + (buf) * AT_BUF + (8 * wid + i_) * AT_KP), 16, 0, 0); \
        __builtin_amdgcn_global_load_lds((const unsigned*)(vg + (size_t)(tile) * 64 * 256 + i_ * 256), (LDSP unsigned*)(lds + (buf) * AT_BUF + AT_VOFF + (8 * wid + i_) * AT_VP), 16, 0, 0); } } } while (0)
    AT_DMA(0, 0);
    for (int tile = 0; tile < ntile; ++tile) {
        asm volatile("s_waitcnt vmcnt(0)" ::: "memory");
        __syncthreads();
        if (tile + 1 < ntile) AT_DMA(tile + 1, (tile + 1) & 1);
        const LDSP unsigned char* kp = lds + (tile & 1) * AT_BUF + c * AT_KP + kvh * 256 + hi * 16;
        const LDSP unsigned char* vp = lds + (tile & 1) * AT_BUF + AT_VOFF + (4 * hi + (i16 >> 2)) * AT_VP + (kvh * 128 + 16 * ((lane >> 4) & 1) + 4 * (i16 & 3)) * 2;
        const unsigned long long mw = maskL[posl * MASK_STRIDE + tile];
        const unsigned wlo = (unsigned)mw >> (4 * hi), whi = (unsigned)(mw >> 32) >> (4 * hi);
        f32x16 S0, S1;
#pragma unroll
        for (int i = 0; i < 16; ++i) { S0[i] = 0.f; S1[i] = 0.f; }
#pragma unroll
        for (int ks = 0; ks < 8; ++ks) {
            const bf16x8 a0 = *(const LDSP bf16x8*)(kp + ks * 32), a1 = *(const LDSP bf16x8*)(kp + 32 * AT_KP + ks * 32);
            S0 = MFMA32(a0, Qf[ks], S0); S1 = MFMA32(a1, Qf[ks], S1);
        }
        float mt = -INFINITY;
#pragma unroll
        for (int i = 0; i < 16; ++i) { const int bit = (i & 3) + 8 * (i >> 2);
            S0[i] = ((wlo >> bit) & 1u) ? S0[i] : -INFINITY; S1[i] = ((whi >> bit) & 1u) ? S1[i] : -INFINITY;
            mt = fmaxf(mt, fmaxf(S0[i], S1[i])); }
        mt = fmaxf(mt, __shfl_xor(mt, 32));
        const float m_new = fmaxf(m_run, mt); const float alpha = __builtin_amdgcn_exp2f(m_run - m_new); m_run = m_new;
        float ls = 0.f;
#pragma unroll
        for (int i = 0; i < 16; ++i) { S0[i] = __builtin_amdgcn_exp2f(S0[i] - m_new); S1[i] = __builtin_amdgcn_exp2f(S1[i] - m_new); ls += S0[i] + S1[i]; }
        l_run = l_run * alpha + ls;
#pragma unroll
        for (int dt = 0; dt < 4; ++dt)
#pragma unroll
            for (int i = 0; i < 16; ++i) Oa[dt][i] *= alpha;
        bf16x8 pf[4];
        pf[0] = pack8(S0[0], S0[1], S0[2], S0[3], S0[4], S0[5], S0[6], S0[7]); pf[1] = pack8(S0[8], S0[9], S0[10], S0[11], S0[12], S0[13], S0[14], S0[15]);
        pf[2] = pack8(S1[0], S1[1], S1[2], S1[3], S1[4], S1[5], S1[6], S1[7]); pf[3] = pack8(S1[8], S1[9], S1[10], S1[11], S1[12], S1[13], S1[14], S1[15]);
#pragma unroll
        for (int dt = 0; dt < 4; ++dt)
#pragma unroll
            for (int j = 0; j < 4; ++j) { const LDSP unsigned char* vj = vp + (16 * j) * AT_VP + dt * 64;
                const bf16x8 a = cat4(vtr(vj), vtr(vj + 8 * AT_VP));
                Oa[dt] = MFMA32(a, pf[j], Oa[dt]); }
    }
#undef AT_DMA
    const float lt = l_run + __shfl_xor(l_run, 32); const float inv = 1.0f / lt;
    bf16_t* op = O + qrow * 1024 + (kvh * 4 + g) * 128 + 4 * hi;
#pragma unroll
    for (int dt = 0; dt < 4; ++dt)
#pragma unroll
        for (int qd = 0; qd < 4; ++qd) { f32x4 v = {Oa[dt][4 * qd] * inv, Oa[dt][4 * qd + 1] * inv, Oa[dt][4 * qd + 2] * inv, Oa[dt][4 * qd + 3] * inv}; st_bf16x4(op + 32 * dt + 8 * qd, v); }
}

__device__ __forceinline__ void dsa_prompt_block(const Ptrs& P, LDSP unsigned char* lds, int n, int qb, int tid, int wid, int lane) {
    const bf16_t* Q = (const bf16_t*)(P.ws + WS_ACT + B_Q); const bf16_t* KB = (const bf16_t*)(P.ws + WS_ACT + B_KB); const bf16_t* VB = (const bf16_t*)(P.ws + WS_ACT + B_VB);
    const bf16_t* QI = (const bf16_t*)(P.ws + WS_ACT + B_QI); const bf16_t* KI = (const bf16_t*)(P.ws + WS_ACT + B_KI); const float* WI = (const float*)(P.ws + WS_ACT + B_WI);
    bf16_t* O = (bf16_t*)(P.ws + WS_ACT + B_O);
    LDSP unsigned* sc = (LDSP unsigned*)lds; LDSP unsigned long long* maskL = (LDSP unsigned long long*)(lds + MASK_OFF);
    const int rowbase = n * SEQ, q0 = 32 * qb, nkt = qb + 1;
    LDSP float* wtab = (LDSP float*)(lds + 16 * SCS * 4);
    for (int sub = 0; sub < 2; ++sub) {
        const int qa = q0 + 16 * sub;
        if (tid < 128) wtab[tid] = WI[(size_t)(rowbase + qa) * 8 + tid] * IDXS;
        __syncthreads();
        index_prompt(sc, (const LDSP f32x4*)wtab, QI, KI, rowbase, qa, nkt, wid, lane);
        __syncthreads();
#pragma unroll 1
        for (int rr = 0; rr < 2; ++rr) { const int ql = 2 * wid + rr; select_row(sc + ql * SCS, 32 * nkt, qa + ql + 1, maskL + (16 * sub + ql) * MASK_STRIDE, lane); }
        __syncthreads();
    }
    attn_qblock(lds, maskL, Q, KB, VB, O, rowbase, q0, (qb >> 1) + 1, tid, wid, lane);
    __syncthreads();
}

__device__ __forceinline__ void dsa_sample_item(const Ptrs& P, LDSP unsigned char* lds, int jB, int nd, int tp, int tid, int wid, int lane) {
    const bf16_t* Q = (const bf16_t*)(P.ws + WS_ACT + B_Q); const bf16_t* QI = (const bf16_t*)(P.ws + WS_ACT + B_QI); const bf16_t* KI = (const bf16_t*)(P.ws + WS_ACT + B_KI);
    const float* WI = (const float*)(P.ws + WS_ACT + B_WI); bf16_t* O = (bf16_t*)(P.ws + WS_ACT + B_O);
    LDSP unsigned* sc = (LDSP unsigned*)lds; LDSP unsigned long long* maskL = (LDSP unsigned long long*)(lds + MASK_OFF);
    LDSP int* list = (LDSP int*)(lds + 17408); LDSP int* pt = (LDSP int*)(lds + 19456);
    LDSP f32x4* sS = (LDSP f32x4*)(lds + 20480); LDSP f32x4* Opart = (LDSP f32x4*)(lds + 36864); LDSP float* ML = (LDSP float*)(lds + 69632);
    const int t0 = 2 * tp;
    if (tid < 16) pt[tid] = P.page_table[nd * 16 + tid];
    __syncthreads();
    index_sample(sc, QI, WI, KI, P.cache_kidx + (size_t)jB * NPOOL * 128 * 64, pt, nd, t0, wid, lane);
    __syncthreads();
    if (wid < 2) {
        select_row(sc + wid * SCS, 65 * 32, SEQ + t0 + wid + 1, maskL + wid * MASK_STRIDE, lane);
        int base = 0;
        for (int r = 0; r < 33; ++r) { const unsigned long long w = maskL[wid * MASK_STRIDE + r];
            const int pre = (int)__builtin_amdgcn_mbcnt_hi((unsigned)(w >> 32), __builtin_amdgcn_mbcnt_lo((unsigned)w, 0u));
            if ((w >> lane) & 1ull) { const int p = base + pre; if (p < KTOP) list[wid * KTOP + p] = 64 * r + lane; }
            base += __builtin_popcountll(w); }
    }
    __syncthreads();
    const int ql = wid >> 2, part = wid & 3, t = t0 + ql;
    const int kvh = lane >> 5, l31 = lane & 31;
    const size_t qrow = (size_t)(TP + 4 * nd + t);
    f32x4 qv[4];
#pragma unroll
    for (int g = 0; g < 4; ++g) { const u32x2 w = *(const u32x2*)(Q + qrow * 1024 + (kvh * 4 + g) * 128 + 4 * l31); qv[g] = (f32x4){bf_lo(w.x), bf_hi(w.x), bf_lo(w.y), bf_hi(w.y)}; }
    const int myidx = list[ql * KTOP + 64 * part + lane];
    const float* ck = P.cache_k + (size_t)jB * NPOOL * 128 * 256; const float* cv = P.cache_v + (size_t)jB * NPOOL * 128 * 256;
    const float* nk = P.out + O_NKS + (size_t)jB * TS * 256; const float* nv = P.out + O_NVS + (size_t)jB * TS * 256;
    LDSP f32x4* sw = sS + (wid * 2) * 64;
#pragma unroll 4
    for (int kk = 0; kk < 64; ++kk) {
        const int idx = __shfl(myidx, kk);
        const float* kr = (idx < SEQ) ? ck + ((size_t)pt[idx >> 7] * 128 + (idx & 127)) * 256 : nk + (size_t)(4 * nd + idx - SEQ) * 256;
        const f32x4 kv = *(const f32x4*)(kr + 4 * lane);
        f32x4 s;
#pragma unroll
        for (int g = 0; g < 4; ++g) { float d = (qv[g][0] * kv[0] + qv[g][1] * kv[1]) + (qv[g][2] * kv[2] + qv[g][3] * kv[3]);
            d += __shfl_xor(d, 1); d += __shfl_xor(d, 2); d += __shfl_xor(d, 4); d += __shfl_xor(d, 8); d += __shfl_xor(d, 16); s[g] = d; }
        if (l31 == 0) sw[kvh * 64 + kk] = s;
    }
    asm volatile("s_waitcnt lgkmcnt(0)" ::: "memory");
    float mw[2][4], lw[2][4];
#pragma unroll
    for (int h2 = 0; h2 < 2; ++h2) {
        f32x4 s = sw[h2 * 64 + lane]; f32x4 p;
#pragma unroll
        for (int g = 0; g < 4; ++g) { const float m = wmax_f(s[g]); p[g] = __builtin_amdgcn_exp2f(s[g] - m); mw[h2][g] = m; lw[h2][g] = wsum(p[g]); }
        sw[h2 * 64 + lane] = p;
    }
    asm volatile("s_waitcnt lgkmcnt(0)" ::: "memory");
    f32x4 oa[4];
#pragma unroll
    for (int g = 0; g < 4; ++g) oa[g] = (f32x4){0.f, 0.f, 0.f, 0.f};
#pragma unroll 4
    for (int kk = 0; kk < 64; ++kk) {
        const int idx = __shfl(myidx, kk);
        const float* vr = (idx < SEQ) ? cv + ((size_t)pt[idx >> 7] * 128 + (idx & 127)) * 256 : nv + (size_t)(4 * nd + idx - SEQ) * 256;
        const f32x4 vv = *(const f32x4*)(vr + 4 * lane); const f32x4 p = sw[kvh * 64 + kk];
#pragma unroll
        for (int g = 0; g < 4; ++g) oa[g] += vv * p[g];
    }
#pragma unroll
    for (int g = 0; g < 4; ++g) Opart[(wid * 64 + lane) * 4 + g] = oa[g];
    if (lane == 0) {
#pragma unroll
        for (int h2 = 0; h2 < 2; ++h2)
#pragma unroll
            for (int g = 0; g < 4; ++g) { ML[((wid * 2 + h2) * 4 + g) * 2] = mw[h2][g]; ML[((wid * 2 + h2) * 4 + g) * 2 + 1] = lw[h2][g]; }
    }
    __syncthreads();
    if (part == 0) {
        f32x4 acc4[4]; float M[4], L[4];
#pragma unroll
        for (int g = 0; g < 4; ++g) { M[g] = -INFINITY; L[g] = 0.f; acc4[g] = (f32x4){0.f, 0.f, 0.f, 0.f}; }
#pragma unroll
        for (int pp = 0; pp < 4; ++pp)
#pragma unroll
            for (int g = 0; g < 4; ++g) M[g] = fmaxf(M[g], ML[(((ql * 4 + pp) * 2 + kvh) * 4 + g) * 2]);
#pragma unroll
        for (int pp = 0; pp < 4; ++pp)
#pragma unroll
            for (int g = 0; g < 4; ++g) { const float m = ML[(((ql * 4 + pp) * 2 + kvh) * 4 + g) * 2], l = ML[(((ql * 4 + pp) * 2 + kvh) * 4 + g) * 2 + 1];
                const float f = __builtin_amdgcn_exp2f(m - M[g]); L[g] += l * f; acc4[g] += Opart[((ql * 4 + pp) * 64 + lane) * 4 + g] * f; }
#pragma unroll
        for (int g = 0; g < 4; ++g) st_bf16x4(O + qrow * 1024 + (kvh * 4 + g) * 128 + 4 * l31, acc4[g] * (1.0f / L[g]));
    }
    __syncthreads();
}

constexpr int N_PHASES = 22;
struct Args { const void* in[18]; float* out; unsigned char* ws; float invA[16]; float invI[8]; int ph_lo, ph_hi; };
static_assert(sizeof(Args) == 18 * 8 + 8 + 8 + 64 + 32 + 8, "Args has no padding");

__global__ void __launch_bounds__(512, 2) mk_fwd(Args args) {
    extern __shared__ __attribute__((aligned(16))) unsigned char lds_raw[];
    LDSP unsigned char* lds = (LDSP unsigned char*)lds_raw;
    const int wid0 = __builtin_amdgcn_readfirstlane((int)threadIdx.x >> 6);
    int lane, tid, wid;
#define FRESH_TID() do { wid = wid0; asm volatile("" : "+s"(wid)); asm volatile("v_mbcnt_lo_u32_b32 %0, -1, 0\n\tv_mbcnt_hi_u32_b32 %0, -1, %0" : "=v"(lane)); tid = wid * 64 + lane; } while (0)
    FRESH_TID();
    const int G = gridDim.x, bx = blockIdx.x;
    const int vcu = (G % 8 == 0) ? (bx % 8) * (G / 8) + bx / 8 : bx;
    const int NGW = G * 8;
    for (int u = tid; u < (LDS_BYTES - MISC_OFF) / 4; u += 512) ((LDSP unsigned*)(lds + MISC_OFF))[u] = 0u;
    __syncthreads();
    {
#pragma unroll
        for (int k = 0; k < 18; ++k) if (tid == k) *(LDSP unsigned long long*)(lds + MISC_OFF + 256 + 8 * k) = (unsigned long long)args.in[k];
    }
    __syncthreads();
#define LDPTR(k) ((const void*)(((unsigned long long)(unsigned)__builtin_amdgcn_readlane((int)phi_, (k)) << 32) | (unsigned long long)(unsigned)__builtin_amdgcn_readlane((int)plo_, (k))))
#define LOAD_P() Ptrs P; do { const unsigned long long pv_ = *(volatile LDSP unsigned long long*)(lds + MISC_OFF + 256 + 8 * (lane < 18 ? lane : 0)); const unsigned plo_ = (unsigned)pv_, phi_ = (unsigned)(pv_ >> 32); \
    P.xp = (const float*)LDPTR(0); P.xs = (const float*)LDPTR(1); P.cache_k = (const float*)LDPTR(2); P.cache_v = (const float*)LDPTR(3); P.cache_kidx = (const float*)LDPTR(4); \
    P.page_table = (const int*)LDPTR(5); P.norm_mix = (const float*)LDPTR(6); P.norm_ffn = (const float*)LDPTR(7); P.a_w_in = (const float*)LDPTR(8); P.a_v_gain = (const float*)LDPTR(9); \
    P.a_w_s = (const float*)LDPTR(10); P.a_b_s = (const float*)LDPTR(11); P.a_w_out = (const float*)LDPTR(12); P.b_w_in = (const float*)LDPTR(13); P.b_w_out = (const float*)LDPTR(14); \
    P.ffn_w1 = (const float*)LDPTR(15); P.ffn_w2 = (const float*)LDPTR(16); P.norm_final = (const float*)LDPTR(17); P.out = args.out; P.ws = args.ws; } while (0)
    XcdBarrier bar = xcd_barrier_post((unsigned*)(args.ws + WS_CTL) + CW_BAR, (volatile LAS unsigned*)(lds + MISC_OFF + 32));
#ifndef MK_LAST_PHASE
#define MK_LAST_PHASE 21
#endif
#define IN(k) ((k) <= MK_LAST_PHASE)
#define SEAM(k) do { if ((k) + 1 <= MK_LAST_PHASE) { XcdBarrier b_ = bar; asm volatile("" : "+s"(b_.bar), "+s"(b_.x)); xcd_barrier(b_); } } while (0)

    unsigned char* const ws = args.ws;
    float* X = (float*)(ws + WS_X); bf16_t* xb = (bf16_t*)(ws + WS_XB); float* ssq = (float*)(ws + WS_SSQ);
    bf16_t* act = (bf16_t*)(ws + WS_ACT);

    if (IN(0)) {
        float myinv = 0.f;
#pragma unroll
        for (int k = 0; k < 16; ++k) if (lane == k) myinv = args.invA[k];
#pragma unroll
        for (int k = 0; k < 8; ++k) if (lane == 16 + k) myinv = args.invI[k];
        LOAD_P(); prologue(P, lds, myinv, vcu * 8 + wid, NGW, wid, lane);
    }
    SEAM(0);

    for (int layer = 0; layer < 4; ++layer) {
        const int j = layer >> 1, ph = 1 + 5 * layer;
        if ((layer & 1) == 0) {
            if (IN(ph)) {
                pg8::Gemm g{xb, (const bf16_t*)(ws + WS_WAIN) + (size_t)j * 2048 * D, T, 2048, D}; pg8::StaticOrder S; S.init(T, 2048, G, bx);
                EpiA1 E{ssq, (bf16_t*)(ws + WS_ACT + A_UB), (bf16_t*)(ws + WS_ACT + A_VB)};
                pg8::gemm_phase<EpiA1, pg8::StaticOrder, true, true>(lds, g, S, E, wid0);
            }
            SEAM(ph);
            if (IN(ph + 1)) {
                FRESH_TID(); LOAD_P();
                for (int u = bx; u < 256; u += G) mix_prompt(P, lds, j, u, tid, wid, lane);
                for (int u = bx; u < 128; u += G) mix_sample(P, lds, j, u, tid, wid, lane);
            }
            SEAM(ph + 1);
            if (IN(ph + 2)) {
                pg8::Gemm g{(const bf16_t*)(ws + WS_ACT + A_UM), (const bf16_t*)(ws + WS_WAOUT) + (size_t)j * D * D, T, D, D}; pg8::StaticOrder S; S.init(T, D, G, bx);
                EpiRes E{X, xb, ssq};
                pg8::gemm_phase<EpiRes, pg8::StaticOrder, true, true>(lds, g, S, E, wid0);
            }
            SEAM(ph + 2);
        } else {
            if (IN(ph)) {
                pg8::Gemm g{xb, (const bf16_t*)(ws + WS_WBIN) + (size_t)j * NBPAD * D, T, NBPAD, D}; pg8::StaticOrder S; S.init(T, NBPAD, G, bx);
                EpiB1 E{ws, args.out, j};
                pg8::gemm_phase<EpiB1, pg8::StaticOrder, true, true>(lds, g, S, E, wid0);
            }
            SEAM(ph);
            if (IN(ph + 1)) {
                FRESH_TID(); LOAD_P();
                for (int u = bx; u < 256; u += G) { const int n = u & 7, i = u >> 3;
#pragma unroll 1
                    for (int pass = 0; pass < 2; ++pass) dsa_prompt_block(P, lds, n, pass ? 63 - i : i, tid, wid, lane); }
                for (int u = bx; u < 256; u += G) dsa_sample_item(P, lds, j, u >> 1, u & 1, tid, wid, lane);
            }
            SEAM(ph + 1);
            if (IN(ph + 2)) {
                pg8::Gemm g{(const bf16_t*)(ws + WS_ACT + B_O), (const bf16_t*)(ws + WS_WBOUT) + (size_t)j * D * D, T, D, D}; pg8::StaticOrder S; S.init(T, D, G, bx);
                EpiRes E{X, xb, ssq};
                pg8::gemm_phase<EpiRes, pg8::StaticOrder, true, true>(lds, g, S, E, wid0);
            }
            SEAM(ph + 2);
        }
        if (IN(ph + 3)) {
            pg8::Gemm g{xb, (const bf16_t*)(ws + WS_W1) + (size_t)layer * FF * D, T, FF, D}; pg8::StaticOrder S; S.init(T, FF, G, bx);
            EpiF1 E{ssq, act};
            pg8::gemm_phase<EpiF1, pg8::StaticOrder, true, true>(lds, g, S, E, wid0);
        }
        SEAM(ph + 3);
        if (IN(ph + 4)) {
            pg8::Gemm g{act, (const bf16_t*)(ws + WS_W2) + (size_t)layer * D * FF, T, D, FF}; pg8::StaticOrder S; S.init(T, D, G, bx);
            EpiRes E{X, xb, ssq};
            pg8::gemm_phase<EpiRes, pg8::StaticOrder, true, true>(lds, g, S, E, wid0);
        }
        SEAM(ph + 4);
    }
    if (IN(21)) { FRESH_TID(); LOAD_P(); final_norm(P, vcu * 8 + wid, NGW, lane); }
#undef IN
#undef SEAM
#undef FRESH_TID
#undef LOAD_P
#undef LDPTR
}
}

extern "C" void kernel_launch(void* const* d_in, const int* in_sizes, int n_in, void* d_out, int out_size, void* d_ws, size_t ws_size, hipStream_t stream) {
    static int grid = 0;
    if (grid == 0) {
        if (n_in != 18 || out_size != (int)mk::O_END || ws_size < mk::WS_END) { fprintf(stderr, "kernel_launch: unexpected problem (n_in %d, out %d, ws %zu); nothing launched\n", n_in, out_size, ws_size); grid = -1; return; }
        int dev = 0, cus = 0, per_cu = 0;
        if (hipGetDevice(&dev) != hipSuccess || hipDeviceGetAttribute(&cus, hipDeviceAttributeMultiprocessorCount, dev) != hipSuccess) { grid = -1; return; }
        if (hipFuncSetAttribute((const void*)mk::mk_fwd, hipFuncAttributeMaxDynamicSharedMemorySize, mk::LDS_BYTES) != hipSuccess) { fprintf(stderr, "kernel_launch: hipFuncSetAttribute failed\n"); grid = -1; return; }
        if (hipOccupancyMaxActiveBlocksPerMultiprocessor(&per_cu, (const void*)mk::mk_fwd, 512, mk::LDS_BYTES) != hipSuccess || per_cu < 1)
            fprintf(stderr, "kernel_launch: note: occupancy query reports %d workgroups per CU\n", per_cu);
        (void)hipGetLastError();
        grid = cus;
    }
    if (grid < 0) return;
    if (hipMemsetAsync((char*)d_ws + mk::WS_CTL, 0, mk::CTL_ZERO_BYTES, stream) != hipSuccess) { fprintf(stderr, "kernel_launch: memset failed\n"); return; }
    mk::Args a{};
    for (int i = 0; i < 18; ++i) a.in[i] = d_in[i];
    a.out = (float*)d_out; a.ws = (unsigned char*)d_ws;
    for (int i = 0; i < 16; ++i) a.invA[i] = (float)pow(500000.0, -(double)i / 16.0);
    for (int i = 0; i < 8; ++i) a.invI[i] = (float)pow(500000.0, -(double)i / 8.0);
    a.ph_lo = 0; a.ph_hi = mk::N_PHASES;
    hipLaunchKernelGGL(mk::mk_fwd, dim3(grid), dim3(512), mk::LDS_BYTES, stream, a);
    const hipError_t le = hipPeekAtLastError();
    if (le != hipSuccess) fprintf(stderr, "kernel_launch: launch failed: %s\n", hipGetErrorName(le));
}
```

```cpp
#include <hip/hip_runtime.h>
#include <cstdio>
#include <cstdint>
#include <cmath>
namespace pg8 {
#define PG8_LAS __attribute__((address_space(3)))
typedef unsigned short bf16_t;
typedef short bf16x8 __attribute__((ext_vector_type(8)));
typedef float f32x4 __attribute__((ext_vector_type(4)));
typedef unsigned u32x4 __attribute__((ext_vector_type(4)));
constexpr int BM = 256, BK = 64, HALF = 128, HTB = HALF * BK * 2  , STAGE_BYTES = 8 * HTB, NXCD = 8, WGM = 4;

__host__ __device__ __forceinline__ int lds_byte(int r, int c) { const int st = (r >> 4) * 2 + (c >> 5), rr = r & 15, cc = c & 31, ob = rr * 64 + cc * 2; return st * 1024 + (ob ^ (((ob >> 9) & 1) << 5)); }
__host__ __device__ __forceinline__ void stage_rc(int b, int& R, int& C) { const int st = b / 1024, sb = b % 1024, swz = sb ^ (((sb >> 9) & 1) << 5); R = (st >> 1) * 16 + swz / 64; C = (st & 1) * 32 + (swz % 64) / 2; }
__host__ __device__ __forceinline__ int perm32(int rho) { const int n = rho >> 4, i = rho & 15; return 8 * (i >> 2) + 4 * n + (i & 3); }

struct Unit { int pm, pn; };
struct Gemm { const bf16_t* A; const bf16_t* Bt; int M, N, K; };

struct StaticOrder {
    int nM, nN, nwg, G, c;
    __host__ __device__ void init(int M, int N, int G_, int c_) { nM = M / BM; nN = N / BM; nwg = nM * nN; G = G_; c = c_; }
    __host__ __device__ bool next(int i, Unit& u) const {
        const long L = (long)i * G + c; if (L >= nwg) return false;
        int wgid = (int)L; { const int q = nwg / NXCD, r = nwg % NXCD, xcd = wgid % NXCD, off = wgid / NXCD; wgid = (xcd < r ? xcd * (q + 1) : r * (q + 1) + (xcd - r) * q) + off; }
        const int nig = WGM * nN, gid = wgid / nig, fm = gid * WGM, gsz = (nM - fm) < WGM ? (nM - fm) : WGM;
        u.pm = fm + ((wgid % nig) % gsz); u.pn = (wgid % nig) / gsz; return true;
    }
    __device__ __forceinline__ void a_ready(const Unit&) const {}
    __device__ __forceinline__ void done(const Unit&) const {}
};

__device__ __forceinline__ unsigned cvt_pk_bf16(float lo, float hi) { unsigned r; asm volatile("v_cvt_pk_bf16_f32 %0, %1, %2" : "=v"(r) : "v"(lo), "v"(hi)); return r; }
template <class Epi, class Sched, bool ALIGN_EPI = false, bool SP2 = false>
__device__ __forceinline__ void gemm_phase(PG8_LAS unsigned char* lds, const Gemm g, const Sched& S, const Epi& E, const int wid_in  ) {
    int lane_; asm volatile("v_mbcnt_lo_u32_b32 %0, -1, 0\n\tv_mbcnt_hi_u32_b32 %0, -1, %0" : "=v"(lane_));
    int wid_ = wid_in; asm volatile("" : "+s"(wid_));
    const int wid = wid_, lane = lane_, tid = wid * 64 + lane, wr = wid >> 2, wc = wid & 3, fr = lane & 15, fq = lane >> 4;
    const int K = g.K, nt = K / BK;
    unsigned voffA[2], voffB[2];
#pragma unroll
    for (int i = 0; i < 2; ++i) { int R, C; stage_rc(tid * 16 + i * 8192, R, C); const int Rb = Epi::PERM ? ((R & ~31) + perm32(R & 31)) : R;
        voffA[i] = (unsigned)(R * K + C) * 2u; voffB[i] = (unsigned)(Rb * K + C) * 2u; }
    const size_t kstep = (size_t)(BK * 2);
    const size_t hstep = (size_t)HALF * K * 2;
    const size_t tstep = 2 * hstep;
    const unsigned ldsw = (unsigned)wid * 1024u;
    const int aoff = lds_byte(wr * 64 + fr, fq * 8), boff = lds_byte(wc * 32 + fr, fq * 8);
#define PG8_SA(b, h) (((b) * 2 + (h)) * HTB)
#define PG8_SB(b, h) ((4 + (b) * 2 + (h)) * HTB)
#define PG8_STAGE(bufoff, gbase, voff) do { _Pragma("unroll") for (int _i = 0; _i < 2; ++_i) \
        __builtin_amdgcn_global_load_lds((const unsigned*)((const char*)(gbase) + (voff)[_i]), (PG8_LAS unsigned*)(lds + (bufoff) + ldsw + _i * 8192), 16, 0, 0); } while (0)
#define PG8_LDA(dst, b, h) do { _Pragma("unroll") for (int m = 0; m < 4; ++m) _Pragma("unroll") for (int k = 0; k < 2; ++k) dst[m][k] = *(const PG8_LAS bf16x8*)(lds + PG8_SA(b, h) + aoff + m * 2048 + k * 1024); } while (0)
#define PG8_LDB(dst, b, h) do { _Pragma("unroll") for (int n = 0; n < 2; ++n) _Pragma("unroll") for (int k = 0; k < 2; ++k) dst[n][k] = *(const PG8_LAS bf16x8*)(lds + PG8_SB(b, h) + boff + n * 2048 + k * 1024); } while (0)
#define PG8_MMA(ai, bj, At, Bt) do { __builtin_amdgcn_s_setprio(1); _Pragma("unroll") for (int m = 0; m < 4; ++m) _Pragma("unroll") for (int n = 0; n < 2; ++n) _Pragma("unroll") for (int k = 0; k < 2; ++k) \
        acc[ai][bj][m][n] = __builtin_amdgcn_mfma_f32_16x16x32_bf16(Bt[n][k], At[m][k], acc[ai][bj][m][n], 0, 0, 0); __builtin_amdgcn_s_setprio(0); } while (0)
#define PG8_WAIT_V(n) asm volatile("s_waitcnt vmcnt(" #n ")" ::: "memory")
#define PG8_WAIT_L(n) asm volatile("s_waitcnt lgkmcnt(" #n ")" ::: "memory")
#define PG8_BAR __builtin_amdgcn_s_barrier()
#define PG8_SCHED __builtin_amdgcn_sched_barrier(0)
    Unit cur, nxt; int ui = 0;
    if (!S.next(0, cur)) return;
    f32x4 acc[2][2][4][2];
#pragma unroll
    for (int a = 0; a < 2; ++a)
#pragma unroll
        for (int b = 0; b < 2; ++b)
#pragma unroll
            for (int m = 0; m < 4; ++m)
#pragma unroll
                for (int n = 0; n < 2; ++n) acc[a][b][m][n] = (f32x4){0.f, 0.f, 0.f, 0.f};
    bf16x8 At[4][2], B0[2][2], B1[2][2];
    const char* cA = (const char*)g.A + (size_t)cur.pm * tstep; const char* cB = (const char*)g.Bt + (size_t)cur.pn * tstep;
    S.a_ready(cur);
    if constexpr (SP2) {
        PG8_STAGE(PG8_SB(0, 0), cB, voffB); PG8_STAGE(PG8_SB(0, 1), cB + hstep, voffB); PG8_STAGE(PG8_SA(0, 0), cA, voffA); PG8_STAGE(PG8_SA(0, 1), cA + hstep, voffA);
        if (wr == 1) PG8_BAR;
        PG8_WAIT_V(2); PG8_BAR;
        PG8_STAGE(PG8_SB(1, 0), cB + kstep, voffB); PG8_STAGE(PG8_SA(1, 0), cA + kstep, voffA); PG8_STAGE(PG8_SB(1, 1), cB + hstep + kstep, voffB);
        PG8_WAIT_V(6); PG8_BAR;
    } else {
        PG8_STAGE(PG8_SB(0, 0), cB, voffB); PG8_STAGE(PG8_SA(0, 0), cA, voffA); PG8_STAGE(PG8_SB(0, 1), cB + hstep, voffB); PG8_STAGE(PG8_SA(0, 1), cA + hstep, voffA);
        if (wr == 1) PG8_BAR;
        PG8_WAIT_V(4); PG8_BAR;
        PG8_STAGE(PG8_SB(1, 0), cB + kstep, voffB); PG8_STAGE(PG8_SA(1, 0), cA + kstep, voffA); PG8_STAGE(PG8_SB(1, 1), cB + hstep + kstep, voffB);
        PG8_WAIT_V(6); PG8_BAR;
    }
    for (;;) {
        const bool has_next = S.next(ui + 1, nxt);
        const char* nA = has_next ? (const char*)g.A + (size_t)nxt.pm * tstep : cA; const char* nB = has_next ? (const char*)g.Bt + (size_t)nxt.pn * tstep : cB;
        for (int t = 0; t < nt; t += 2) {
            const bool last = (t == nt - 2);
            const char* a1 = cA + (size_t)(t + 1) * kstep;
            const char* a2 = last ? nA : cA + (size_t)(t + 2) * kstep; const char* b2 = last ? nB : cB + (size_t)(t + 2) * kstep;
            const char* a3 = a2 + kstep; const char* b3 = b2 + kstep;
            if (last && has_next) S.a_ready(nxt);
            if constexpr (SP2) {
            PG8_LDB(B0, 0, 0); PG8_LDB(B1, 0, 1); PG8_SCHED; PG8_LDA(At, 0, 0); PG8_STAGE(PG8_SA(1, 1), a1 + hstep, voffA);
            PG8_WAIT_V(8); PG8_WAIT_L(0); PG8_BAR; PG8_MMA(0, 0, At, B0); PG8_MMA(0, 1, At, B1); PG8_BAR; PG8_SCHED;
            PG8_LDA(At, 0, 1); PG8_STAGE(PG8_SB(0, 0), b2, voffB); PG8_STAGE(PG8_SB(0, 1), b2 + hstep, voffB); PG8_STAGE(PG8_SA(0, 0), a2, voffA);
            PG8_WAIT_V(8); PG8_WAIT_L(0); PG8_BAR; PG8_MMA(1, 0, At, B0); PG8_MMA(1, 1, At, B1); PG8_BAR; PG8_SCHED;
            PG8_LDB(B0, 1, 0); PG8_LDB(B1, 1, 1); PG8_SCHED; PG8_LDA(At, 1, 0); PG8_STAGE(PG8_SA(0, 1), a2 + hstep, voffA);
            PG8_WAIT_V(8); PG8_WAIT_L(0); PG8_BAR; PG8_MMA(0, 0, At, B0); PG8_MMA(0, 1, At, B1); PG8_BAR; PG8_SCHED;
            PG8_LDA(At, 1, 1); PG8_STAGE(PG8_SB(1, 0), b3, voffB); PG8_STAGE(PG8_SB(1, 1), b3 + hstep, voffB); PG8_STAGE(PG8_SA(1, 0), a3, voffA);
            PG8_WAIT_V(8); PG8_WAIT_L(0); PG8_BAR; PG8_MMA(1, 0, At, B0); PG8_MMA(1, 1, At, B1); PG8_BAR; PG8_SCHED;
            } else {
            PG8_LDB(B0, 0, 0); PG8_SCHED; PG8_LDA(At, 0, 0); PG8_STAGE(PG8_SA(1, 1), a1 + hstep, voffA);
            PG8_WAIT_L(8); PG8_BAR; PG8_WAIT_L(0); PG8_MMA(0, 0, At, B0); PG8_BAR; PG8_SCHED;
            PG8_LDB(B1, 0, 1); PG8_STAGE(PG8_SB(0, 0), b2, voffB);
            PG8_BAR; PG8_WAIT_L(0); PG8_MMA(0, 1, At, B1); PG8_BAR;
            PG8_LDA(At, 0, 1); PG8_STAGE(PG8_SA(0, 0), a2, voffA);
            PG8_BAR; PG8_WAIT_L(0); PG8_MMA(1, 0, At, B0); PG8_BAR; PG8_SCHED;
            PG8_STAGE(PG8_SB(0, 1), b2 + hstep, voffB);
            PG8_WAIT_V(6); PG8_BAR; PG8_MMA(1, 1, At, B1); PG8_BAR;
            PG8_LDB(B0, 1, 0); PG8_SCHED; PG8_LDA(At, 1, 0); PG8_STAGE(PG8_SA(0, 1), a2 + hstep, voffA);
            PG8_WAIT_L(8); PG8_BAR; PG8_WAIT_L(0); PG8_MMA(0, 0, At, B0); PG8_BAR; PG8_SCHED;
            PG8_LDB(B1, 1, 1); PG8_STAGE(PG8_SB(1, 0), b3, voffB);
            PG8_BAR; PG8_WAIT_L(0); PG8_MMA(0, 1, At, B1); PG8_BAR;
            PG8_LDA(At, 1, 1); PG8_STAGE(PG8_SA(1, 0), a3, voffA);
            PG8_BAR; PG8_WAIT_L(0); PG8_MMA(1, 0, At, B0); PG8_BAR; PG8_SCHED;
            PG8_STAGE(PG8_SB(1, 1), b3 + hstep, voffB);
            PG8_WAIT_V(6); PG8_BAR; PG8_MMA(1, 1, At, B1); PG8_BAR;
            }
        }
        if constexpr (ALIGN_EPI) { if (wr == 0) PG8_BAR; }
        if constexpr (!Epi::AFTER_DRAIN) { E(acc, cur, wr, wc, fr, fq); S.done(cur); }
        if (!has_next) break;
#pragma unroll
        for (int a = 0; a < 2; ++a)
#pragma unroll
            for (int b = 0; b < 2; ++b)
#pragma unroll
                for (int m = 0; m < 4; ++m)
#pragma unroll
                    for (int n = 0; n < 2; ++n) acc[a][b][m][n] = (f32x4){0.f, 0.f, 0.f, 0.f};
        cur = nxt; cA = nA; cB = nB; ++ui;
        if constexpr (ALIGN_EPI) { if (wr == 1) PG8_BAR; }
    }
    PG8_WAIT_V(0);
    if constexpr (!ALIGN_EPI) { if (wr == 0) PG8_BAR; }
    PG8_BAR;
    if constexpr (Epi::AFTER_DRAIN) { E.fused(acc, cur, wr, wc, fr, fq, lds, wid, lane); S.done(cur); }
#undef PG8_SA
#undef PG8_SB
#undef PG8_STAGE
#undef PG8_LDA
#undef PG8_LDB
#undef PG8_MMA
#undef PG8_WAIT_V
#undef PG8_WAIT_L
#undef PG8_BAR
#undef PG8_SCHED
}
}

#define GAS __attribute__((address_space(1)))
#define LAS __attribute__((address_space(3)))
typedef unsigned short bf16;
typedef unsigned v4u __attribute__((ext_vector_type(4)));
typedef float f32x4 __attribute__((ext_vector_type(4)));
typedef short bf16x8 __attribute__((ext_vector_type(8)));
typedef GAS unsigned gu32;
typedef GAS unsigned long long gu64;
#define RLX_AGENT __ATOMIC_RELAXED, __HIP_MEMORY_SCOPE_AGENT
#define LDS_WAIT() asm volatile("s_waitcnt lgkmcnt(0)" ::: "memory")
#define VM_WAIT() asm volatile("s_waitcnt vmcnt(0)" ::: "memory")
__device__ __forceinline__ unsigned long long rt() { return __builtin_amdgcn_s_memrealtime(); }
__device__ __forceinline__ unsigned f2bf(float f) { unsigned u = __builtin_bit_cast(unsigned, f); return (u + 0x7fffu + ((u >> 16) & 1u)) >> 16; }
__device__ __forceinline__ unsigned pk2(float lo, float hi) { return f2bf(lo) | (f2bf(hi) << 16); }

#define XB_TMO      128
#define XB_XCNT(j)  (256  + 64 * (j))
#define XB_XSUB(j)  (1280 + 64 * (j))
#define XB_XGEN(j)  (2304 + 64 * (j))
#define XB_TOP      3328
#define XB_TOPGEN   3392
#define XCD_BAR_WORDS 3456
#define XB_SPIN_CAP (1u << 18)

__device__ __forceinline__ unsigned xb_ld(unsigned* p)              { return __hip_atomic_load(p, __ATOMIC_RELAXED, __HIP_MEMORY_SCOPE_AGENT); }
__device__ __forceinline__ unsigned xb_add(unsigned* p, unsigned v) { return __hip_atomic_fetch_add(p, v, __ATOMIC_RELAXED, __HIP_MEMORY_SCOPE_AGENT); }
__device__ __forceinline__ unsigned xb_xcc_id() { return (unsigned)__builtin_amdgcn_s_getreg((3 << 11) | 20) & 0xFu; }
#define XB_SPIN(cond, bar) do { unsigned _sp = 0; while (cond) { __builtin_amdgcn_s_sleep(1); \
    if ((++_sp & 255u) == 0u) { if (xb_ld(&(bar)[XB_TMO])) break; if (_sp > XB_SPIN_CAP) { atomicAdd(&(bar)[XB_TMO], 1u); break; } } } } while (0)

struct XcdBarrier {
    unsigned* bar; unsigned x;
    volatile LAS unsigned* st;
};

__device__ __forceinline__ XcdBarrier xcd_barrier_post(unsigned* bar, volatile LAS unsigned* st) {
    XcdBarrier b; b.bar = bar; b.x = xb_xcc_id(); b.st = st;
    if (threadIdx.x == 0) (void)xb_add(&bar[XB_XCNT(b.x)], 1u);
    return b;
}
__device__ __forceinline__ void xcd_barrier_complete(unsigned* bar, unsigned x, unsigned& nloc, unsigned& nx) {
    const unsigned G = gridDim.x * gridDim.y * gridDim.z;
    unsigned sum, cnt, mine, sp = 0u;
    for (;;) {
        sum = 0u; cnt = 0u; mine = 0u;
#pragma unroll
        for (unsigned j = 0; j < 16; ++j) { const unsigned c = xb_ld(&bar[XB_XCNT(j)]); sum += c; cnt += (c > 0u) ? 1u : 0u; mine = (j == x) ? c : mine; }
        if (sum == G) break;
        __builtin_amdgcn_s_sleep(1);
        if ((++sp & 255u) == 0u) { if (xb_ld(&bar[XB_TMO])) break; if (sp > XB_SPIN_CAP) { atomicAdd(&bar[XB_TMO], 1u); break; } }
    }
    nloc = mine > 0u ? mine : 1u; nx = cnt > 0u ? cnt : 1u;
}

__device__ __forceinline__ void xcd_barrier(const XcdBarrier& b) {
    asm volatile("s_waitcnt vmcnt(0)" ::: "memory");
    __syncthreads();
    if (threadIdx.x == 0) {
        unsigned* bar = b.bar;
        __builtin_amdgcn_s_waitcnt(0);
        unsigned nloc = b.st[0], nx = b.st[1];
        if (nloc == 0u) { xcd_barrier_complete(bar, b.x, nloc, nx); b.st[0] = nloc; b.st[1] = nx; }
        const unsigned old = xb_add(&bar[XB_XSUB(b.x)], 1u);
        const unsigned gen = old / nloc;
        if (old + 1u == (gen + 1u) * nloc) {
            __builtin_amdgcn_fence(__ATOMIC_RELEASE, "agent");
            asm volatile("s_waitcnt vmcnt(0)" ::: "memory");
            const unsigned og = xb_add(&bar[XB_TOP], 1u);
            const unsigned tg = og / nx;
            if (og + 1u == (tg + 1u) * nx) xb_add(&bar[XB_TOPGEN], 1u);
            else XB_SPIN(xb_ld(&bar[XB_TOPGEN]) == tg, bar);
            __builtin_amdgcn_fence(__ATOMIC_ACQUIRE, "agent");
            xb_add(&bar[XB_XGEN(b.x)], 1u);
            asm volatile("s_waitcnt vmcnt(0)" ::: "memory");
        } else {
            XB_SPIN(xb_ld(&bar[XB_XGEN(b.x)]) == gen, bar);
            __builtin_amdgcn_fence(__ATOMIC_ACQUIRE, "agent");
            asm volatile("s_waitcnt vmcnt(0)" ::: "memory");
        }
    }
    __syncthreads();
}


namespace mk {
using pg8::bf16_t; using pg8::bf16x8; using pg8::f32x4; using pg8::u32x4; using pg8::Unit;
typedef float f32x16 __attribute__((ext_vector_type(16)));
typedef float f32x2 __attribute__((ext_vector_type(2)));
typedef unsigned u32x2 __attribute__((ext_vector_type(2)));
typedef short s16x4 __attribute__((ext_vector_type(4)));
typedef short v4i16_t __attribute__((ext_vector_type(4)));
#define LDSP __attribute__((address_space(3)))
#define MFMA32(a, b, c) __builtin_amdgcn_mfma_f32_32x32x16_bf16((a), (b), (c), 0, 0, 0)

constexpr int D = 1024, TP = 16384, TS = 512, T = TP + TS, SEQ = 2048, FF = 4096;
constexpr int NBP = 2120, NBPAD = 2304, NPOOL = 2560;
constexpr float EPS = 1e-6f;
constexpr float IDXS = 0.04419417382415922f;
constexpr float QSCALE = 0.08838834764831845f * 1.4426950408889634f;
constexpr int KTOP = 256;

constexpr size_t MiB = 1u << 20;
constexpr size_t WS_CTL = 0, CTL_ZERO_BYTES = 32768;
constexpr size_t WS_ROPEA = 1 * MiB, WS_ROPEI = 1 * MiB + 512 * 1024;
constexpr size_t WS_SSQ = 2 * MiB;
constexpr size_t WS_WAIN = 4 * MiB, WS_WAOUT = 12 * MiB, WS_WBIN = 16 * MiB, WS_WBOUT = 26 * MiB, WS_W1 = 30 * MiB, WS_W2 = 62 * MiB;
constexpr size_t WS_X = 94 * MiB, WS_XB = 160 * MiB, WS_ACT = 194 * MiB, WS_END = 326 * MiB;
constexpr size_t A_UB = 0, A_VB = 33 * MiB, A_UM = 66 * MiB;
constexpr size_t B_Q = 0, B_KB = 33 * MiB, B_VB = 42 * MiB, B_QI = 51 * MiB, B_KI = 68 * MiB, B_WI = 71 * MiB, B_O = 72 * MiB;
constexpr int CW_BAR = 4096;
constexpr size_t O_Y = 0, O_NKP = 17301504, O_NVP = 25690112, O_NKIP = 34078720, O_NKS = 36175872, O_NVS = 36438016, O_NKIS = 36700160, O_CVP = 36765696, O_CVS = 38862848, O_END = 39911424;
constexpr int R0_BYTES = 141312;
constexpr int MASK_OFF = R0_BYTES, MASK_STRIDE = 34;
constexpr int MISC_OFF = MASK_OFF + 32 * MASK_STRIDE * 8;
constexpr int SEL_OFF = MISC_OFF + 2048;
constexpr int LDS_BYTES = SEL_OFF + 8 * 1280;
static_assert(LDS_BYTES <= 163840, "LDS map");
constexpr int SCS = 2112;

__device__ __forceinline__ unsigned pk_bf16(float lo, float hi) {
    typedef float f2_t __attribute__((ext_vector_type(2))); typedef __bf16 b2_t __attribute__((ext_vector_type(2)));
    f2_t v = {lo, hi}; b2_t b = __builtin_convertvector(v, b2_t); return __builtin_bit_cast(unsigned, b);
}
__device__ __forceinline__ float bf_lo(unsigned w) { return __uint_as_float(w << 16); }
__device__ __forceinline__ float bf_hi(unsigned w) { return __uint_as_float(w & 0xffff0000u); }
__device__ __forceinline__ float wsum(float v) {
#pragma unroll
    for (int o = 1; o < 64; o <<= 1) v += __shfl_xor(v, o);
    return v;
}
__device__ __forceinline__ int wsum_i(int v) {
#pragma unroll
    for (int o = 1; o < 64; o <<= 1) v += __shfl_xor(v, o);
    return v;
}
__device__ __forceinline__ float wmax_f(float v) {
#pragma unroll
    for (int o = 1; o < 64; o <<= 1) v = fmaxf(v, __shfl_xor(v, o));
    return v;
}
__device__ __forceinline__ unsigned wmax_u(unsigned v) {
#pragma unroll
    for (int o = 1; o < 64; o <<= 1) { const unsigned t = (unsigned)__shfl_xor((int)v, o); v = t > v ? t : v; }
    return v;
}
__device__ __forceinline__ unsigned wmin_u(unsigned v) {
#pragma unroll
    for (int o = 1; o < 64; o <<= 1) { const unsigned t = (unsigned)__shfl_xor((int)v, o); v = t < v ? t : v; }
    return v;
}
__device__ __forceinline__ unsigned wmax_u_dpp(unsigned v) {
    unsigned t;
    t = (unsigned)__builtin_amdgcn_update_dpp(0, (int)v, 0xB1, 0xF, 0xF, false); v = t > v ? t : v;
    t = (unsigned)__builtin_amdgcn_update_dpp(0, (int)v, 0x4E, 0xF, 0xF, false); v = t > v ? t : v;
    t = (unsigned)__builtin_amdgcn_update_dpp(0, (int)v, 0x141, 0xF, 0xF, false); v = t > v ? t : v;
    t = (unsigned)__builtin_amdgcn_update_dpp(0, (int)v, 0x140, 0xF, 0xF, false); v = t > v ? t : v;
    const unsigned a = (unsigned)__builtin_amdgcn_readlane((int)v, 0), b = (unsigned)__builtin_amdgcn_readlane((int)v, 16), c = (unsigned)__builtin_amdgcn_readlane((int)v, 32), d = (unsigned)__builtin_amdgcn_readlane((int)v, 48);
    const unsigned ab = a > b ? a : b, cd = c > d ? c : d; return ab > cd ? ab : cd;
}
__device__ __forceinline__ unsigned wmin_u_dpp(unsigned v) { return ~wmax_u_dpp(~v); }
__device__ __forceinline__ float wsum_dpp(float v) {
    v += __int_as_float(__builtin_amdgcn_update_dpp(0, __float_as_int(v), 0xB1, 0xF, 0xF, false)); v += __int_as_float(__builtin_amdgcn_update_dpp(0, __float_as_int(v), 0x4E, 0xF, 0xF, false));
    v += __int_as_float(__builtin_amdgcn_update_dpp(0, __float_as_int(v), 0x141, 0xF, 0xF, false)); v += __int_as_float(__builtin_amdgcn_update_dpp(0, __float_as_int(v), 0x140, 0xF, 0xF, false));
    const int i = __float_as_int(v);
    return (__int_as_float(__builtin_amdgcn_readlane(i, 0)) + __int_as_float(__builtin_amdgcn_readlane(i, 16))) + (__int_as_float(__builtin_amdgcn_readlane(i, 32)) + __int_as_float(__builtin_amdgcn_readlane(i, 48)));
}
__device__ __forceinline__ unsigned fkey(float s) { s = s + 0.0f; const unsigned u = __float_as_uint(s); return (u & 0x80000000u) ? ~u : (u | 0x80000000u); }
__device__ __forceinline__ float unkey(unsigned k) { return __uint_as_float((k & 0x80000000u) ? (k ^ 0x80000000u) : ~k); }
__device__ __forceinline__ float rscale(const float* ssq, int row, int fq) {
    const f32x4 p = *(const f32x4*)(ssq + (size_t)row * 16 + 4 * fq);
    float s = (p[0] + p[1]) + (p[2] + p[3]);
    s += __shfl_xor(s, 16); s += __shfl_xor(s, 32);
    return rsqrtf(s * (1.0f / 1024.0f) + EPS);
}
__device__ __forceinline__ void rscale8(const float* ssq, int row0, int fq, float (&r)[8], float mul) {
    f32x4 p[8];
#pragma unroll
    for (int q = 0; q < 8; ++q) p[q] = *(const f32x4*)(ssq + (size_t)(row0 + (q >> 2) * 128 + (q & 3) * 16) * 16 + 4 * fq);
#pragma unroll
    for (int q = 0; q < 8; ++q) { float s = (p[q][0] + p[q][1]) + (p[q][2] + p[q][3]); s += __shfl_xor(s, 16); s += __shfl_xor(s, 32); r[q] = rsqrtf(s * (1.0f / 1024.0f) + EPS) * mul; }
}
__device__ __forceinline__ float gelu_t(float x) {
    const float y = x * (0.7978845608f + 0.0356774081f * x * x);
    const float e = __builtin_amdgcn_exp2f(-2.885390082f * y);
    return x * __builtin_amdgcn_rcpf(1.0f + e);
}
__device__ __forceinline__ void st_bf16x4(bf16_t* p, const f32x4 v) { u32x2 w; w.x = pk_bf16(v[0], v[1]); w.y = pk_bf16(v[2], v[3]); *(u32x2*)p = w; }
__device__ __forceinline__ void st_bf16x8(bf16_t* p, const f32x4 a, const f32x4 b) { u32x4 w; w.x = pk_bf16(a[0], a[1]); w.y = pk_bf16(a[2], a[3]); w.z = pk_bf16(b[0], b[1]); w.w = pk_bf16(b[2], b[3]); *(u32x4*)p = w; }
__device__ __forceinline__ void st_bf16x8_nt(bf16_t* p, const f32x4 a, const f32x4 b) { u32x4 w; w.x = pk_bf16(a[0], a[1]); w.y = pk_bf16(a[2], a[3]); w.z = pk_bf16(b[0], b[1]); w.w = pk_bf16(b[2], b[3]); __builtin_nontemporal_store(w, (u32x4*)p); }
__device__ __forceinline__ s16x4 vtr(const LDSP unsigned char* p) { return __builtin_bit_cast(s16x4, __builtin_amdgcn_ds_read_tr16_b64_v4i16((LDSP v4i16_t*)p)); }
__device__ __forceinline__ bf16x8 cat4(const s16x4 a, const s16x4 b) { return (bf16x8){a[0], a[1], a[2], a[3], b[0], b[1], b[2], b[3]}; }
__device__ __forceinline__ bf16x8 pack8(float a0, float a1, float a2, float a3, float a4, float a5, float a6, float a7) {
    u32x4 w; w.x = pk_bf16(a0, a1); w.y = pk_bf16(a2, a3); w.z = pk_bf16(a4, a5); w.w = pk_bf16(a6, a7); return __builtin_bit_cast(bf16x8, w);
}

__device__ __forceinline__ int fresh_lane() { int l; asm volatile("v_mbcnt_lo_u32_b32 %0, -1, 0\n\tv_mbcnt_hi_u32_b32 %0, -1, %0" : "=v"(l)); return l; }
struct EpiA1 {
    static constexpr bool PERM = true, AFTER_DRAIN = false;
    const float* ssq; bf16_t* ub; bf16_t* vb; float* vstat;
    __device__ __forceinline__ void operator()(const f32x4 (&acc)[2][2][4][2], const Unit& u, int wr, int wc, int fr, int fq) const {
        const bool isv = u.pn >= 4;
        bf16_t* base = (u.pn < 4 ? ub : vb) + (u.pn & 3) * 256 + wc * 32 + 8 * fq;
        const int row0 = u.pm * 256 + wr * 64 + fr;
        float rs[8]; rscale8(ssq, row0, fq, rs, 1.0f);
#pragma unroll
        for (int ai = 0; ai < 2; ++ai)
#pragma unroll
            for (int m = 0; m < 4; ++m) {
                const int row = row0 + ai * 128 + m * 16; const float r = rs[ai * 4 + m];
                bf16_t* rp = base + (size_t)row * 1024; float s1 = 0.f, s2 = 0.f;
#pragma unroll
                for (int bj = 0; bj < 2; ++bj) { f32x4 v0 = acc[ai][bj][m][0] * r, v1 = acc[ai][bj][m][1] * r;
#pragma unroll
                    for (int j = 0; j < 4; ++j) { v0[j] = gelu_t(v0[j]); v1[j] = gelu_t(v1[j]); s1 += v0[j] + v1[j]; s2 += v0[j] * v0[j] + v1[j] * v1[j]; }
                    st_bf16x8(rp + bj * 128, v0, v1); }
                if (isv) { s1 += __shfl_xor(s1, 16); s1 += __shfl_xor(s1, 32); s2 += __shfl_xor(s2, 16); s2 += __shfl_xor(s2, 32);
                    if (fq == 0) *(f32x2*)(vstat + ((size_t)row * 16 + (u.pn - 4) * 4 + wc) * 2) = (f32x2){s1, s2}; }
            }
    }
};
struct EpiF1 {
    static constexpr bool PERM = true, AFTER_DRAIN = false;
    const float* ssq; bf16_t* a;
    __device__ __forceinline__ void operator()(const f32x4 (&acc)[2][2][4][2], const Unit& u, int wr, int wc, int fr, int fq) const {
        bf16_t* base = a + u.pn * 256 + wc * 32 + 8 * fq;
        const int row0 = u.pm * 256 + wr * 64 + fr;
        float rs[8]; rscale8(ssq, row0, fq, rs, 1.0f);
#pragma unroll
        for (int ai = 0; ai < 2; ++ai)
#pragma unroll
            for (int m = 0; m < 4; ++m) {
                const int row = row0 + ai * 128 + m * 16; const float r = rs[ai * 4 + m];
                bf16_t* rp = base + (size_t)row * FF;
#pragma unroll
                for (int bj = 0; bj < 2; ++bj) { f32x4 v0 = acc[ai][bj][m][0] * r, v1 = acc[ai][bj][m][1] * r;
#pragma unroll
                    for (int j = 0; j < 4; ++j) { const float t0 = fmaxf(v0[j], 0.f), t1 = fmaxf(v1[j], 0.f); v0[j] = t0 * t0; v1[j] = t1 * t1; }
                    st_bf16x8(rp + bj * 128, v0, v1); }
            }
    }
};
struct EpiRes {
    static constexpr bool PERM = true, AFTER_DRAIN = false;
    bf16_t* xb; float* ssq;
    __device__ __forceinline__ void operator()(const f32x4 (&acc)[2][2][4][2], const Unit& u, int wr, int wc, int fr, int fq) const {
        const int col0 = u.pn * 256 + wc * 32 + 8 * fq;
        const int row0 = u.pm * 256 + wr * 64 + fr;
        u32x4 xin[2][4][2];
#pragma unroll
        for (int ai = 0; ai < 2; ++ai)
#pragma unroll
            for (int m = 0; m < 4; ++m)
#pragma unroll
                for (int bj = 0; bj < 2; ++bj) xin[ai][m][bj] = *(const u32x4*)(xb + (size_t)(row0 + ai * 128 + m * 16) * 1024 + col0 + bj * 128);
#pragma unroll
        for (int ai = 0; ai < 2; ++ai) {
#pragma unroll
            for (int m = 0; m < 4; ++m) {
                const int row = row0 + ai * 128 + m * 16; float q = 0.f;
                bf16_t* br = xb + (size_t)row * 1024 + col0;
#pragma unroll
                for (int bj = 0; bj < 2; ++bj) { const u32x4 xo = xin[ai][m][bj];
                    const f32x4 x0 = (f32x4){bf_lo(xo.x), bf_hi(xo.x), bf_lo(xo.y), bf_hi(xo.y)} + acc[ai][bj][m][0], x1 = (f32x4){bf_lo(xo.z), bf_hi(xo.z), bf_lo(xo.w), bf_hi(xo.w)} + acc[ai][bj][m][1];
                    st_bf16x8(br + bj * 128, x0, x1);
                    q += ((x0[0] * x0[0] + x0[1] * x0[1]) + (x0[2] * x0[2] + x0[3] * x0[3])) + ((x1[0] * x1[0] + x1[1] * x1[1]) + (x1[2] * x1[2] + x1[3] * x1[3])); }
                q += __shfl_xor(q, 16); q += __shfl_xor(q, 32);
                if (fq == 0) ssq[(size_t)row * 16 + u.pn * 4 + wc] = q;
            }
        }
    }
};
__device__ __forceinline__ void rope_pair(f32x4& v0, f32x4& v1, const f32x4 ca, const f32x4 cb) {
#pragma unroll
    for (int j = 0; j < 4; ++j) { const float c = (j < 2 ? ca : cb)[2 * (j & 1)], s = (j < 2 ? ca : cb)[2 * (j & 1) + 1];
        const float x1 = v0[j], x2 = v1[j]; v0[j] = x1 * c - x2 * s; v1[j] = x2 * c + x1 * s; }
}
__device__ __forceinline__ void rope_idx(f32x4& v0, const float* ropeI, int pos, int fq) {
    const float* cp = ropeI + ((size_t)pos * 8 + 4 * (fq & 1)) * 2;
    const f32x4 ca = *(const f32x4*)cp, cb = *(const f32x4*)(cp + 4);
#pragma unroll
    for (int j = 0; j < 4; ++j) { const float c = (j < 2 ? ca : cb)[2 * (j & 1)], s = (j < 2 ? ca : cb)[2 * (j & 1) + 1];
        const float own = v0[j], oth = __shfl_xor(own, 32);
        v0[j] = (fq < 2) ? own * c - oth * s : own * c + oth * s; }
}
struct EpiB1 {
    static constexpr bool PERM = false, AFTER_DRAIN = false;
    unsigned char* ws; float* out; int jB;
    __device__ __forceinline__ void operator()(const f32x4 (&acc)[2][2][4][2], const Unit& u, int wr, int wc, int fr, int fq) const {
        const int pn = u.pn;
        const int row0 = u.pm * 256 + wr * 64 + fr;
        const float* ssq = (const float*)(ws + WS_SSQ);
        float rs[8]; rscale8(ssq, row0, fq, rs, pn < 4 ? QSCALE : 1.0f);
        if (pn < 4) {
            const float* ropeA = (const float*)(ws + WS_ROPEA); bf16_t* Q = (bf16_t*)(ws + WS_ACT + B_Q);
#pragma unroll
            for (int ai = 0; ai < 2; ++ai)
#pragma unroll
                for (int m = 0; m < 4; ++m) {
                    const int row = row0 + ai * 128 + m * 16; const float r = rs[ai * 4 + m];
                    const int pos = row & (SEQ - 1);
                    f32x4 ca = {0.f, 0.f, 0.f, 0.f}, cb = ca;
                    if (wc == 0) { const float* cp = ropeA + ((size_t)pos * 16 + 4 * fq) * 2; ca = *(const f32x4*)cp; cb = *(const f32x4*)(cp + 4); }
                    bf16_t* rp = Q + (size_t)row * 1024 + pn * 256 + wc * 32 + 4 * fq;
#pragma unroll
                    for (int bj = 0; bj < 2; ++bj) { f32x4 v0 = acc[ai][bj][m][0] * r, v1 = acc[ai][bj][m][1] * r;
                        if (wc == 0) rope_pair(v0, v1, ca, cb);
                        st_bf16x4(rp + bj * 128, v0); st_bf16x4(rp + bj * 128 + 16, v1); }
                }
        } else if (pn < 6) {
            const float* ropeA = (const float*)(ws + WS_ROPEA);
            float* of = out + ((pn == 4) ? O_NKP : O_NVP) + (size_t)jB * TP * 256;
            bf16_t* ob = (bf16_t*)(ws + WS_ACT + ((pn == 4) ? B_KB : B_VB));
            const bool rot = (pn == 4) && (wc == 0);
#pragma unroll
            for (int ai = 0; ai < 2; ++ai)
#pragma unroll
                for (int m = 0; m < 4; ++m) {
                    const int row = row0 + ai * 128 + m * 16; const float r = rs[ai * 4 + m];
                    const int pos = row & (SEQ - 1);
                    f32x4 ca = {0.f, 0.f, 0.f, 0.f}, cb = ca;
                    if (rot) { const float* cp = ropeA + ((size_t)pos * 16 + 4 * fq) * 2; ca = *(const f32x4*)cp; cb = *(const f32x4*)(cp + 4); }
                    float* fp = of + (size_t)row * 256 + wc * 32 + 4 * fq; bf16_t* bp = ob + (size_t)row * 256 + wc * 32 + 4 * fq;
#pragma unroll
                    for (int bj = 0; bj < 2; ++bj) { f32x4 v0 = acc[ai][bj][m][0] * r, v1 = acc[ai][bj][m][1] * r;
                        if (rot) rope_pair(v0, v1, ca, cb);
                        *(f32x4*)(fp + bj * 128) = v0; *(f32x4*)(fp + bj * 128 + 16) = v1;
                        st_bf16x4(bp + bj * 128, v0); st_bf16x4(bp + bj * 128 + 16, v1); }
                }
        } else {
            const float* ropeI = (const float*)(ws + WS_ROPEI); bf16_t* QI = (bf16_t*)(ws + WS_ACT + B_QI);
#pragma unroll
            for (int ai = 0; ai < 2; ++ai)
#pragma unroll
                for (int m = 0; m < 4; ++m) {
                    const int row = row0 + ai * 128 + m * 16; const float r = rs[ai * 4 + m];
                    const int pos = row & (SEQ - 1);
                    bf16_t* rp = QI + (size_t)row * 512 + (pn - 6) * 256 + wc * 32 + 4 * fq;
#pragma unroll
                    for (int bj = 0; bj < 2; ++bj) { f32x4 v0 = acc[ai][bj][m][0] * r, v1 = acc[ai][bj][m][1] * r;
                        if ((wc & 1) == 0) rope_idx(v0, ropeI, pos, fq);
                        st_bf16x4(rp + bj * 128, v0); st_bf16x4(rp + bj * 128 + 16, v1); }
                }
        }
    }
};

__device__ __forceinline__ float rscale_row(const float* ssq, int row, int hi) {
    const float* p = ssq + (size_t)row * 16 + 8 * hi; const f32x4 a = *(const f32x4*)p, b = *(const f32x4*)(p + 4);
    float s = ((a[0] + a[1]) + (a[2] + a[3])) + ((b[0] + b[1]) + (b[2] + b[3]));
    s += __shfl_xor(s, 32);
    return rsqrtf(s * (1.0f / 1024.0f) + EPS);
}
struct SEpiA1 { static constexpr bool SSQ = false; const float* ssq; bf16_t* ub; bf16_t* vb;
    typedef float Pre;
    __device__ __forceinline__ Pre pre(int row, int col0, int hi) const { return rscale_row(ssq, row, hi); }
    __device__ __forceinline__ float operator()(const f32x16& acc, const Pre& r, int row, int col0, int hi) const {
        bf16_t* base = (col0 < 1024 ? ub : vb) + (size_t)row * 1024 + (col0 & 1023) + 4 * hi;
#pragma unroll
        for (int qd = 0; qd < 4; ++qd) { f32x4 v = {gelu_t(acc[4 * qd] * r), gelu_t(acc[4 * qd + 1] * r), gelu_t(acc[4 * qd + 2] * r), gelu_t(acc[4 * qd + 3] * r)}; st_bf16x4(base + 8 * qd, v); }
        return 0.f; } };
struct SEpiF1 { static constexpr bool SSQ = false; const float* ssq; bf16_t* a;
    typedef float Pre;
    __device__ __forceinline__ Pre pre(int row, int col0, int hi) const { return rscale_row(ssq, row, hi); }
    __device__ __forceinline__ float operator()(const f32x16& acc, const Pre& r, int row, int col0, int hi) const {
        bf16_t* base = a + (size_t)row * FF + col0 + 4 * hi;
#pragma unroll
        for (int qd = 0; qd < 4; ++qd) { f32x4 v;
#pragma unroll
            for (int j = 0; j < 4; ++j) { const float t = fmaxf(acc[4 * qd + j] * r, 0.f); v[j] = t * t; }
            st_bf16x4(base + 8 * qd, v); }
        return 0.f; } };
struct SEpiRes { static constexpr bool SSQ = true; bf16_t* xb;
    struct Pre { u32x2 x0, x1, x2, x3; };
    __device__ __forceinline__ Pre pre(int row, int col0, int hi) const { const bf16_t* br = xb + (size_t)row * 1024 + col0 + 4 * hi;
        Pre p; p.x0 = *(const u32x2*)br; p.x1 = *(const u32x2*)(br + 8); p.x2 = *(const u32x2*)(br + 16); p.x3 = *(const u32x2*)(br + 24); return p; }
    __device__ __forceinline__ float operator()(const f32x16& acc, const Pre& pf, int row, int col0, int hi) const {
        bf16_t* br = xb + (size_t)row * 1024 + col0 + 4 * hi; float q = 0.f;
#pragma unroll
        for (int qd = 0; qd < 4; ++qd) { const u32x2 xo = qd == 0 ? pf.x0 : qd == 1 ? pf.x1 : qd == 2 ? pf.x2 : pf.x3; const f32x4 xn = {bf_lo(xo.x) + acc[4 * qd], bf_hi(xo.x) + acc[4 * qd + 1], bf_lo(xo.y) + acc[4 * qd + 2], bf_hi(xo.y) + acc[4 * qd + 3]};
            st_bf16x4(br + 8 * qd, xn); q += (xn[0] * xn[0] + xn[1] * xn[1]) + (xn[2] * xn[2] + xn[3] * xn[3]); }
        q += __shfl_xor(q, 32);
        return q; } };
struct SEpiB1 { static constexpr bool SSQ = false; unsigned char* ws; float* out; int jB;
    typedef float Pre;
    __device__ __forceinline__ Pre pre(int row, int col0, int hi) const { return rscale_row((const float*)(ws + WS_SSQ), row, hi); }
    __device__ __forceinline__ float operator()(const f32x16& acc, const Pre& rpre, int row, int col0, int hi) const {
        const float* ropeA = (const float*)(ws + WS_ROPEA); const float* ropeI = (const float*)(ws + WS_ROPEI);
        const bool samp = row >= TP; const int pos = samp ? SEQ + (row & 3) : (row & (SEQ - 1)), rowo = samp ? row - TP : row;
        float r = rpre;
        float v[16];
        if (col0 < 1024) r *= QSCALE;
#pragma unroll
        for (int i = 0; i < 16; ++i) v[i] = acc[i] * r;
        if (col0 < 1280 && (col0 & 127) == 0) {
#pragma unroll
            for (int qd = 0; qd < 2; ++qd) { const float* cp = ropeA + ((size_t)pos * 16 + 8 * qd + 4 * hi) * 2; const f32x4 ca = *(const f32x4*)cp, cb = *(const f32x4*)(cp + 4);
#pragma unroll
                for (int j = 0; j < 4; ++j) { const float c = (j < 2 ? ca : cb)[2 * (j & 1)], s = (j < 2 ? ca : cb)[2 * (j & 1) + 1];
                    const float x1 = v[4 * qd + j], x2 = v[4 * qd + 8 + j]; v[4 * qd + j] = x1 * c - x2 * s; v[4 * qd + 8 + j] = x2 * c + x1 * s; } }
        } else if (col0 >= 1536 && col0 < 2112 && (col0 & 63) == 0) {
            const float* cp = ropeI + ((size_t)pos * 8 + 4 * hi) * 2; const f32x4 ca = *(const f32x4*)cp, cb = *(const f32x4*)(cp + 4);
#pragma unroll
            for (int j = 0; j < 4; ++j) { const float c = (j < 2 ? ca : cb)[2 * (j & 1)], s = (j < 2 ? ca : cb)[2 * (j & 1) + 1];
                const float x1 = v[j], x2 = v[4 + j]; v[j] = x1 * c - x2 * s; v[4 + j] = x2 * c + x1 * s; }
        }
        if (col0 < 1024) { bf16_t* p = (bf16_t*)(ws + WS_ACT + B_Q) + (size_t)row * 1024 + col0 + 4 * hi;
#pragma unroll
            for (int qd = 0; qd < 4; ++qd) st_bf16x4(p + 8 * qd, (f32x4){v[4 * qd], v[4 * qd + 1], v[4 * qd + 2], v[4 * qd + 3]});
        } else if (col0 < 1536) { const bool isk = col0 < 1280; const int cc = (isk ? col0 - 1024 : col0 - 1280) + 4 * hi;
            float* fp = out + (isk ? O_NKS : O_NVS) + (size_t)jB * TS * 256 + (size_t)rowo * 256 + cc; bf16_t* bp = (bf16_t*)(ws + WS_ACT + (isk ? B_KB : B_VB)) + (size_t)row * 256 + cc;
#pragma unroll
            for (int qd = 0; qd < 4; ++qd) { const f32x4 t = {v[4 * qd], v[4 * qd + 1], v[4 * qd + 2], v[4 * qd + 3]}; *(f32x4*)(fp + 8 * qd) = t; st_bf16x4(bp + 8 * qd, t); }
        } else if (col0 < 2048) { bf16_t* p = (bf16_t*)(ws + WS_ACT + B_QI) + (size_t)row * 512 + (col0 - 1536) + 4 * hi;
#pragma unroll
            for (int qd = 0; qd < 4; ++qd) st_bf16x4(p + 8 * qd, (f32x4){v[4 * qd], v[4 * qd + 1], v[4 * qd + 2], v[4 * qd + 3]});
        } else if (col0 < 2112) { const int cc = col0 - 2048 + 4 * hi;
            float* fp = out + (samp ? O_NKIS + (size_t)jB * TS * 64 : O_NKIP + (size_t)jB * TP * 64) + (size_t)rowo * 64 + cc; bf16_t* bp = (bf16_t*)(ws + WS_ACT + B_KI) + (size_t)row * 64 + cc;
#pragma unroll
            for (int qd = 0; qd < 4; ++qd) { const f32x4 t = {v[4 * qd], v[4 * qd + 1], v[4 * qd + 2], v[4 * qd + 3]}; *(f32x4*)(fp + 8 * qd) = t; st_bf16x4(bp + 8 * qd, t); }
        } else if (col0 == 2112) { *(f32x4*)((float*)(ws + WS_ACT + B_WI) + (size_t)row * 8 + 4 * hi) = (f32x4){v[0], v[1], v[2], v[3]}; }
        return 0.f; } };

template <int TM, int TN, class EpiS, int MODE = 0>
__device__ __forceinline__ void gemm_small(LDSP unsigned char* lds, const bf16_t* A, const bf16_t* Bt, int K, int row_base, int n_rt, int col_base, int n_cg, const EpiS& E, float* ssq, int bx, int G, int wid_in) {
    constexpr int CT = TN / 32, KS = 8 / CT, RT = TM / 32;
    constexpr int KC = 64 * KS;
    constexpr int PITCH = KC * 2 + 16;
    constexpr int QPR = KC / 8;
    constexpr int NPA = TM * QPR, NPIECE = (TM + TN) * QPR, NLD = (NPIECE + 511) / 512;
    constexpr int STAGE = (TM + TN) * PITCH;
    static_assert(2 * STAGE <= R0_BYTES, "small-gemm stages exceed LDS region");
    static_assert(RT * 32768 + TM * CT * 4 <= R0_BYTES, "small-gemm reduce scratch exceeds LDS region");
    int wid = wid_in; asm volatile("" : "+s"(wid));
    const int lane = fresh_lane(); const int c = lane & 31, hi = lane >> 5;
    const int tid = wid * 64 + lane;
    const int ct = wid % CT, ks = wid / CT;
    const int ntile = n_rt * n_cg, nkc = K / KC;
    LDSP f32x16* part = (LDSP f32x16*)lds;
    LDSP float* qs = (LDSP float*)(lds + RT * 32768);
#define GS_OK(i) (NPIECE % 512 == 0 || (i) < NLD - 1 || tid + 512 * (i) < NPIECE)
#define GS_LOAD(slot, kc_) do { _Pragma("unroll") for (int i = 0; i < NLD; ++i) if (GS_OK(i)) pre[slot][i] = *(const u32x4*)(src[i] + (size_t)(kc_) * KC); } while (0)
#define GS_STORE(slot, off) do { _Pragma("unroll") for (int i = 0; i < NLD; ++i) if (GS_OK(i)) *(LDSP u32x4*)(lds + (off) + dst[i]) = pre[slot][i]; } while (0)
#define GS_MMA(off) do { const LDSP unsigned char* sb = lds + (off) + (TM + ct * 32 + c) * PITCH + hi * 16 + ks * 128; const LDSP unsigned char* sa = lds + (off) + c * PITCH + hi * 16 + ks * 128; \
        _Pragma("unroll") for (int s_ = 0; s_ < 4; ++s_) { const bf16x8 wf = *(const LDSP bf16x8*)(sb + s_ * 32); \
            _Pragma("unroll") for (int r_ = 0; r_ < RT; ++r_) acc[r_] = MFMA32(wf, *(const LDSP bf16x8*)(sa + r_ * 32 * PITCH + s_ * 32), acc[r_]); } } while (0)
    for (int t = bx; t < ntile; t += G) {
        int rt = t / n_cg, cg = t - rt * n_cg;
        int row0 = row_base + TM * rt, colb = col_base + cg * TN;
        if (MODE == 1) {
            if (t < TP / TM) { row0 = TM * t; colb = 2048; cg = 0; }
            else { const int u = t - TP / TM; rt = u / 17; cg = u - rt * 17; row0 = TP + TM * rt; colb = cg * TN; }
        }
        const int col0 = colb + ct * 32;
        const bf16_t* src[NLD]; unsigned dst[NLD];
#pragma unroll
        for (int i = 0; i < NLD; ++i) {
            const int p = tid + 512 * i;
            const bool isA = p < NPA;
            const int pp = isA ? p : p - NPA;
            const int r = pp / QPR, q = pp % QPR;
            src[i] = (isA ? A + (size_t)(row0 + r) * K : Bt + (size_t)(colb + r) * K) + q * 8;
            dst[i] = (unsigned)((isA ? r : TM + r) * PITCH + q * 16);
        }
        typename EpiS::Pre epf{}; if (ks < RT) epf = E.pre(row0 + 32 * ks + c, col0, hi);
        u32x4 pre[2][NLD];
        f32x16 acc[RT];
#if defined(MK_PROBE_SK)
#pragma unroll 1
        for (int rep_ = 0; rep_ < 2; ++rep_) {
        asm volatile("" ::: "memory");
#endif
        GS_LOAD(0, 0); GS_LOAD(1, 1);
        GS_STORE(0, 0); GS_LOAD(0, 2);
        __syncthreads();
#pragma unroll
        for (int r = 0; r < RT; ++r)
#pragma unroll
            for (int i = 0; i < 16; ++i) acc[r][i] = 0.f;
        for (int kc = 0; kc < nkc; kc += 2) {
            GS_STORE(1, STAGE); if (kc + 3 < nkc) GS_LOAD(1, kc + 3);
            GS_MMA(0);
            __syncthreads();
            if (kc + 2 < nkc) { GS_STORE(0, 0); if (kc + 4 < nkc) GS_LOAD(0, kc + 4); }
            GS_MMA(STAGE);
            __syncthreads();
        }
#if defined(MK_PROBE_SK)
        }
#endif
        static_assert(KS >= RT && KS > 1, "epilogue deal: one wave per (column slice, row tile)");
#pragma unroll
        for (int r = 0; r < RT; ++r) part[(r * 8 + wid) * 64 + lane] = acc[r];
        __syncthreads();
        float q = 0.f;
        if (ks < RT) {
            f32x16 sum = part[(ks * 8 + ct) * 64 + lane];
#pragma unroll
            for (int s = 1; s < KS; ++s) { const f32x16 o = part[(ks * 8 + s * CT + ct) * 64 + lane];
#pragma unroll
                for (int i = 0; i < 16; ++i) sum[i] += o[i]; }
            q = E(sum, epf, row0 + 32 * ks + c, col0, hi);
        }
        if (EpiS::SSQ) {
            if (ks < RT && hi == 0) qs[ct * TM + 32 * ks + c] = q;
            __syncthreads();
            if (wid == 0 && (RT == 2 || hi == 0)) { float s = 0.f; const int rr = (RT == 2) ? lane : c;
#pragma unroll
                for (int u = 0; u < CT; ++u) s += qs[u * TM + rr];
                ssq[(size_t)(row0 + rr) * 16 + cg] = s; }
        }
        __syncthreads();
    }
#undef GS_OK
#undef GS_LOAD
#undef GS_STORE
#undef GS_MMA
}

__device__ __forceinline__ void transpose_item(const float* W, const float* gain, int K, int N, bf16_t* WT, LDSP float* scr, int item, int nblk, int lane) {
    const int kb = item / nblk, nb = item % nblk, k0 = 64 * kb, n0 = 32 * nb;
    const int nn = n0 + (lane & 31); const bool inb = nn < N;
    float wv[32];
#pragma unroll
    for (int i = 0; i < 32; ++i) { const int kk = 2 * i + (lane >> 5); wv[i] = inb ? W[(size_t)(k0 + kk) * N + nn] : 0.f; }
    if (gain) {
        const float g0 = gain[k0 + lane];
#pragma unroll
        for (int i = 0; i < 32; ++i) wv[i] *= __shfl(g0, 2 * i + (lane >> 5));
    }
#pragma unroll
    for (int i = 0; i < 32; ++i) { const int kk = 2 * i + (lane >> 5); scr[kk * 33 + (lane & 31)] = wv[i]; }
    asm volatile("s_waitcnt lgkmcnt(0)" ::: "memory");
    const int c = lane & 7;
#pragma unroll
    for (int j = 0; j < 4; ++j) { const int n = (lane >> 3) + 8 * j; const LDSP float* s = scr + (8 * c) * 33 + n;
        u32x4 o; o.x = pk_bf16(s[0 * 33], s[1 * 33]); o.y = pk_bf16(s[2 * 33], s[3 * 33]); o.z = pk_bf16(s[4 * 33], s[5 * 33]); o.w = pk_bf16(s[6 * 33], s[7 * 33]);
        *(u32x4*)(WT + (size_t)(n0 + n) * K + k0 + 8 * c) = o; }
    asm volatile("s_waitcnt lgkmcnt(0)" ::: "memory");
}

struct Ptrs {
    const float *xp, *xs, *cache_k, *cache_v, *cache_kidx; const int* page_table;
    const float *norm_mix, *norm_ffn, *a_w_in, *a_v_gain, *a_w_s, *a_b_s, *a_w_out, *b_w_in, *b_w_out, *ffn_w1, *ffn_w2, *norm_final;
    float* out; unsigned char* ws;
};

__device__ __forceinline__ void prologue(const Ptrs& P, LDSP unsigned char* lds, float myinv  , int gw, int NGW, int wid, int lane) {
    LDSP float* scr = (LDSP float*)(lds + wid * 16384);
    constexpr int I_AIN = 16 * 64, I_AOUT = 16 * 32, I_BIN = 16 * 72, I_BOUT = 16 * 32, I_W1 = 16 * 128, I_W2 = 64 * 32;
    constexpr int NITEMS = 2 * (I_AIN + I_AOUT + I_BIN + I_BOUT) + 4 * (I_W1 + I_W2);
    bf16_t* ws_ain = (bf16_t*)(P.ws + WS_WAIN); bf16_t* ws_aout = (bf16_t*)(P.ws + WS_WAOUT); bf16_t* ws_bin = (bf16_t*)(P.ws + WS_WBIN);
    bf16_t* ws_bout = (bf16_t*)(P.ws + WS_WBOUT); bf16_t* ws_w1 = (bf16_t*)(P.ws + WS_W1); bf16_t* ws_w2 = (bf16_t*)(P.ws + WS_W2);
    for (int it = gw; it < NITEMS; it += NGW) {
        int r = it;
        if (r < 2 * I_AIN) { const int j = r / I_AIN; r -= j * I_AIN;
            transpose_item(P.a_w_in + (size_t)j * D * 2048, P.norm_mix + (2 * j) * D, D, 2048, ws_ain + (size_t)j * 2048 * D, scr, r, 64, lane); continue; }
        r -= 2 * I_AIN;
        if (r < 2 * I_AOUT) { const int j = r / I_AOUT; r -= j * I_AOUT;
            transpose_item(P.a_w_out + (size_t)j * D * D, nullptr, D, D, ws_aout + (size_t)j * D * D, scr, r, 32, lane); continue; }
        r -= 2 * I_AOUT;
        if (r < 2 * I_BIN) { const int j = r / I_BIN; r -= j * I_BIN;
            transpose_item(P.b_w_in + (size_t)j * D * NBP, P.norm_mix + (2 * j + 1) * D, D, NBP, ws_bin + (size_t)j * NBPAD * D, scr, r, 72, lane); continue; }
        r -= 2 * I_BIN;
        if (r < 2 * I_BOUT) { const int j = r / I_BOUT; r -= j * I_BOUT;
            transpose_item(P.b_w_out + (size_t)j * D * D, nullptr, D, D, ws_bout + (size_t)j * D * D, scr, r, 32, lane); continue; }
        r -= 2 * I_BOUT;
        if (r < 4 * I_W1) { const int i = r / I_W1; r -= i * I_W1;
            transpose_item(P.ffn_w1 + (size_t)i * D * FF, P.norm_ffn + i * D, D, FF, ws_w1 + (size_t)i * FF * D, scr, r, 128, lane); continue; }
        r -= 4 * I_W1;
        { const int i = r / I_W2; r -= i * I_W2;
            transpose_item(P.ffn_w2 + (size_t)i * FF * D, nullptr, FF, D, ws_w2 + (size_t)i * D * FF, scr, r, 32, lane); }
    }
    bf16_t* xb = (bf16_t*)(P.ws + WS_XB); float* ssq = (float*)(P.ws + WS_SSQ);
    for (int m0 = gw; m0 < T; m0 += 2 * NGW) {
        const int m1 = m0 + NGW; const bool has1 = m1 < T;
        const float* s0 = (m0 < TP) ? P.xp + (size_t)m0 * D : P.xs + (size_t)(m0 - TP) * D;
        const float* s1 = has1 ? ((m1 < TP) ? P.xp + (size_t)m1 * D : P.xs + (size_t)(m1 - TP) * D) : s0;
        f32x4 va[4], vb4[4];
#pragma unroll
        for (int j = 0; j < 4; ++j) { va[j] = *(const f32x4*)(s0 + 256 * j + 4 * lane); vb4[j] = *(const f32x4*)(s1 + 256 * j + 4 * lane); }
#pragma unroll
        for (int rr = 0; rr < 2; ++rr) {
            if (rr == 1 && !has1) break;
            const int m = rr ? m1 : m0;
#pragma unroll
            for (int j = 0; j < 4; ++j) {
                const f32x4 v = rr ? vb4[j] : va[j];
                st_bf16x4(xb + (size_t)m * D + 256 * j + 4 * lane, v);
                float q = (v[0] * v[0] + v[1] * v[1]) + (v[2] * v[2] + v[3] * v[3]);
                q += __shfl_xor(q, 1); q += __shfl_xor(q, 2); q += __shfl_xor(q, 4); q += __shfl_xor(q, 8);
                if ((lane & 15) == 0) ssq[(size_t)m * 16 + 4 * j + (lane >> 4)] = q;
            }
        }
    }
    { bf16_t* wsb = (bf16_t*)(P.ws + WS_X + 4 * MiB);
      for (int e = gw * 64 + lane; e < 2 * 8 * 128 * 16; e += NGW * 64) {
          const int s0 = (e & 15) * 8, t = (e >> 4) & 127;
          const float* src = P.a_w_s + (size_t)(e >> 4) * 128 + s0; const f32x4 a = *(const f32x4*)src, b = *(const f32x4*)(src + 4);
          float w[8] = {a[0], a[1], a[2], a[3], b[0], b[1], b[2], b[3]};
#pragma unroll
          for (int k = 0; k < 8; ++k) if (s0 + k > t) w[k] = 0.f;
          u32x4 o; o.x = pk_bf16(w[0], w[1]); o.y = pk_bf16(w[2], w[3]); o.z = pk_bf16(w[4], w[5]); o.w = pk_bf16(w[6], w[7]);
          *(u32x4*)(wsb + (size_t)(e >> 4) * 128 + s0) = o; } }
    float* ropeA = (float*)(P.ws + WS_ROPEA); float* ropeI = (float*)(P.ws + WS_ROPEI);
    const int gt = gw * 64 + lane, NGT = NGW * 64;
    for (int e = gt; e < 2052 * 24; e += NGT) {
        const int pos = e / 24, i = e % 24;
        const float inv = __shfl(myinv, i);
        const float ang = (float)pos * inv;
        const double a = (double)ang; const double k = rint(a * 0.15915494309189535); const double rr = fma(-k, 6.283185307179586, a);
        const float rf = (float)rr; const float c = cosf(rf), s = sinf(rf);
        float* dst = (i < 16) ? ropeA + ((size_t)pos * 16 + i) * 2 : ropeI + ((size_t)pos * 8 + (i - 16)) * 2;
        dst[0] = c; dst[1] = s;
    }
}

__device__ __forceinline__ void final_norm(const Ptrs& P, int gw, int NGW, int lane) {
    const bf16_t* xb = (const bf16_t*)(P.ws + WS_XB);
    f32x4 gq[4];
#pragma unroll
    for (int j = 0; j < 4; ++j) gq[j] = *(const f32x4*)(P.norm_final + 256 * j + 4 * lane);
    for (int m0 = gw; m0 < T; m0 += 2 * NGW) {
        const int m1 = m0 + NGW; const bool has1 = m1 < T;
        u32x2 w0[4], w1[4];
#pragma unroll
        for (int j = 0; j < 4; ++j) { w0[j] = *(const u32x2*)(xb + (size_t)m0 * D + 256 * j + 4 * lane); w1[j] = has1 ? *(const u32x2*)(xb + (size_t)m1 * D + 256 * j + 4 * lane) : (u32x2){0u, 0u}; }
#pragma unroll
        for (int rr = 0; rr < 2; ++rr) {
            if (rr == 1 && !has1) break;
            const int m = rr ? m1 : m0; f32x4 v[4]; float q = 0.f;
#pragma unroll
            for (int j = 0; j < 4; ++j) { const u32x2 w = rr ? w1[j] : w0[j]; v[j] = (f32x4){bf_lo(w.x), bf_hi(w.x), bf_lo(w.y), bf_hi(w.y)}; q += (v[j][0] * v[j][0] + v[j][1] * v[j][1]) + (v[j][2] * v[j][2] + v[j][3] * v[j][3]); }
            const float r = rsqrtf(wsum_dpp(q) * (1.0f / 1024.0f) + EPS);
#pragma unroll
            for (int j = 0; j < 4; ++j) *(f32x4*)(P.out + O_Y + (size_t)m * D + 256 * j + 4 * lane) = v[j] * r * gq[j];
        }
    }
}

constexpr int MIX_VP = 320;
__device__ __forceinline__ void mix_prompt(const Ptrs& P, LDSP unsigned char* lds, const float* vstat, int jA, int unit, int tid, int wid, int lane) {
    const int n = unit >> 5, c = (unit >> 1) & 15, hf = unit & 1; const int R0 = n * SEQ + c * 128;
    const bf16_t* ub = (const bf16_t*)(P.ws + WS_ACT + A_UB); const bf16_t* vb = (const bf16_t*)(P.ws + WS_ACT + A_VB); bf16_t* um = (bf16_t*)(P.ws + WS_ACT + A_UM);
    const float* gain = P.a_v_gain + jA * D; const float* wsm = P.a_w_s + (size_t)jA * 8 * 128 * 128; const float* bsm = P.a_b_s + jA * 8 * 128;
    LDSP float* st = (LDSP float*)(lds + 128 * MIX_VP);
    { const int s = 16 * wid + (lane & 15); const float* vp4 = vstat + ((size_t)(R0 + s) * 16 + 4 * (lane >> 4)) * 2;
      const f32x4 a = *(const f32x4*)vp4, b = *(const f32x4*)(vp4 + 4);
      float s1 = (a[0] + a[2]) + (b[0] + b[2]), s2 = (a[1] + a[3]) + (b[1] + b[3]);
      s1 += __shfl_xor(s1, 16); s1 += __shfl_xor(s1, 32); s2 += __shfl_xor(s2, 16); s2 += __shfl_xor(s2, 32);
      const float mu = s1 * (1.0f / 1024.0f); const float var = fmaxf(s2 * (1.0f / 1024.0f) - mu * mu, 0.f);
      if (lane < 16) { st[s] = mu; st[128 + s] = rsqrtf(var + EPS); } }
    __syncthreads();
    const int l31 = lane & 31, hi = lane >> 5, i16 = lane & 15;
    const int tt = wid & 3, dh = wid >> 2;
    u32x4 vcur[4], ucur[4], vnxt[4], unxt[4];
#pragma unroll
    for (int k = 0; k < 4; ++k) { const size_t o = (size_t)(R0 + ((tid + 512 * k) >> 4)) * 1024 + (4 * hf) * 128 + (tid & 15) * 8; vcur[k] = *(const u32x4*)(vb + o); ucur[k] = *(const u32x4*)(ub + o); }
#pragma unroll 1
    for (int gg = 0; gg < 4; ++gg) {
        const int g = 4 * hf + gg;
        const int t = 32 * tt + l31; const bf16_t* wrow = (const bf16_t*)(P.ws + WS_X + 4 * MiB) + ((size_t)(jA * 8 + g) * 128 + t) * 128 + 8 * hi;
        const int nks = 2 * tt + 2;
        bf16x8 wq[8];
#pragma unroll
        for (int ks = 0; ks < 8; ++ks) if (ks < nks) wq[ks] = *(const bf16x8*)(wrow + 16 * ks);
        const float* gp = gain + g * 128 + (tid & 15) * 8; const f32x4 g0 = *(const f32x4*)gp, g1 = *(const f32x4*)(gp + 4);
        float biasv[4];
#pragma unroll
        for (int k = 0; k < 4; ++k) biasv[k] = bsm[g * 128 + ((tid + 512 * k) >> 4)];
        if (gg + 1 < 4) {
#pragma unroll
            for (int k = 0; k < 4; ++k) { const size_t o = (size_t)(R0 + ((tid + 512 * k) >> 4)) * 1024 + (g + 1) * 128 + (tid & 15) * 8; vnxt[k] = *(const u32x4*)(vb + o); unxt[k] = *(const u32x4*)(ub + o); }
        }
#pragma unroll
        for (int k = 0; k < 4; ++k) { const int id = tid + 512 * k, s = id >> 4, dc = id & 15;
            const u32x4 a = vcur[k];
            const float mu = st[s], rstd = st[128 + s];
            u32x4 o;
            o.x = pk_bf16((bf_lo(a.x) - mu) * rstd * g0[0], (bf_hi(a.x) - mu) * rstd * g0[1]); o.y = pk_bf16((bf_lo(a.y) - mu) * rstd * g0[2], (bf_hi(a.y) - mu) * rstd * g0[3]);
            o.z = pk_bf16((bf_lo(a.z) - mu) * rstd * g1[0], (bf_hi(a.z) - mu) * rstd * g1[1]); o.w = pk_bf16((bf_lo(a.w) - mu) * rstd * g1[2], (bf_hi(a.w) - mu) * rstd * g1[3]);
            *(LDSP u32x4*)(lds + s * MIX_VP + dc * 16) = o;
            if (c == 15) {
                float* op = P.out + O_CVP + ((size_t)(jA * 8 + n) * 128 + s) * 1024 + g * 128 + dc * 8;
                *(f32x4*)op = (f32x4){(bf_lo(a.x) - mu) * rstd * g0[0], (bf_hi(a.x) - mu) * rstd * g0[1], (bf_lo(a.y) - mu) * rstd * g0[2], (bf_hi(a.y) - mu) * rstd * g0[3]};
                *(f32x4*)(op + 4) = (f32x4){(bf_lo(a.z) - mu) * rstd * g1[0], (bf_hi(a.z) - mu) * rstd * g1[1], (bf_lo(a.w) - mu) * rstd * g1[2], (bf_hi(a.w) - mu) * rstd * g1[3]}; } }
        __syncthreads();
        f32x16 acc0, acc1;
#pragma unroll
        for (int i = 0; i < 16; ++i) { acc0[i] = 0.f; acc1[i] = 0.f; }
        const LDSP unsigned char* vp = lds + (size_t)(8 * hi + (i16 >> 2)) * MIX_VP + (64 * dh + 16 * ((lane >> 4) & 1) + 4 * (i16 & 3)) * 2;
#pragma unroll
        for (int ks = 0; ks < 8; ++ks) if (ks < nks) {
            const bf16x8 bfrag = wq[ks];
            const LDSP unsigned char* vk = vp + (size_t)(16 * ks) * MIX_VP;
            const bf16x8 a0 = cat4(vtr(vk), vtr(vk + 4 * MIX_VP)), a1 = cat4(vtr(vk + 64), vtr(vk + 4 * MIX_VP + 64));
            acc0 = MFMA32(a0, bfrag, acc0); acc1 = MFMA32(a1, bfrag, acc1);
        }
        LDSP float* ot = (LDSP float*)(lds + 49152);
#pragma unroll
        for (int dti = 0; dti < 2; ++dti)
#pragma unroll
            for (int qd = 0; qd < 4; ++qd) { const f32x16& A = dti ? acc1 : acc0;
                *(LDSP f32x4*)(ot + t * 132 + 64 * dh + 32 * dti + 8 * qd + 4 * hi) = (f32x4){A[4 * qd], A[4 * qd + 1], A[4 * qd + 2], A[4 * qd + 3]}; }
        __syncthreads();
#pragma unroll
        for (int k = 0; k < 4; ++k) { const int id = tid + 512 * k, row = id >> 4, dc = id & 15;
            const f32x4 m0 = *(const LDSP f32x4*)(ot + row * 132 + dc * 8), m1 = *(const LDSP f32x4*)(ot + row * 132 + dc * 8 + 4);
            const size_t o = (size_t)(R0 + row) * 1024 + g * 128 + dc * 8;
            const u32x4 uu = ucur[k]; const float bias = biasv[k];
            u32x4 r;
            r.x = pk_bf16(bf_lo(uu.x) * (m0[0] + bias), bf_hi(uu.x) * (m0[1] + bias)); r.y = pk_bf16(bf_lo(uu.y) * (m0[2] + bias), bf_hi(uu.y) * (m0[3] + bias));
            r.z = pk_bf16(bf_lo(uu.z) * (m1[0] + bias), bf_hi(uu.z) * (m1[1] + bias)); r.w = pk_bf16(bf_lo(uu.w) * (m1[2] + bias), bf_hi(uu.w) * (m1[3] + bias));
            *(u32x4*)(um + o) = r; }
#pragma unroll
        for (int k = 0; k < 4; ++k) { vcur[k] = vnxt[k]; ucur[k] = unxt[k]; }
        __syncthreads();
    }
}
__device__ __forceinline__ void mix_sample(const Ptrs& P, LDSP unsigned char* lds, int jA, int nb, int tid, int wid, int lane) {
    const int R0 = TP + 4 * nb;
    const bf16_t* ub = (const bf16_t*)(P.ws + WS_ACT + A_UB); const bf16_t* vb = (const bf16_t*)(P.ws + WS_ACT + A_VB); bf16_t* um = (bf16_t*)(P.ws + WS_ACT + A_UM);
    const float* gain = P.a_v_gain + jA * D; const float* wsm = P.a_w_s + (size_t)jA * 8 * 128 * 128; const float* bsm = P.a_b_s + jA * 8 * 128;
    LDSP float* st = (LDSP float*)lds;
    if (wid < 4) {
        const bf16_t* vr = vb + (size_t)(R0 + wid) * 1024;
        const u32x4 a = *(const u32x4*)(vr + 8 * lane), b = *(const u32x4*)(vr + 512 + 8 * lane);
        float x[16];
#pragma unroll
        for (int k = 0; k < 4; ++k) { x[2 * k] = bf_lo(a[k]); x[2 * k + 1] = bf_hi(a[k]); x[8 + 2 * k] = bf_lo(b[k]); x[8 + 2 * k + 1] = bf_hi(b[k]); }
        float sm = 0.f;
#pragma unroll
        for (int k = 0; k < 16; ++k) sm += x[k];
        const float mu = wsum(sm) * (1.0f / 1024.0f); float sq = 0.f;
#pragma unroll
        for (int k = 0; k < 16; ++k) { const float d = x[k] - mu; sq += d * d; }
        const float rstd = rsqrtf(wsum(sq) * (1.0f / 1024.0f) + EPS);
        if (lane == 0) { st[wid] = mu; st[4 + wid] = rstd; }
    }
    __syncthreads();
    const int col = 2 * tid, g = col >> 7;
    float vn[4][2];
#pragma unroll
    for (int s = 0; s < 4; ++s) { const unsigned w = *(const unsigned*)(vb + (size_t)(R0 + s) * 1024 + col); const float mu = st[s], rstd = st[4 + s];
        vn[s][0] = (bf_lo(w) - mu) * rstd * gain[col]; vn[s][1] = (bf_hi(w) - mu) * rstd * gain[col + 1];
        *(f32x2*)(P.out + O_CVS + ((size_t)(jA * 128 + nb) * 4 + s) * 1024 + col) = (f32x2){vn[s][0], vn[s][1]}; }
#pragma unroll
    for (int t = 0; t < 4; ++t) {
        float m0 = bsm[g * 128 + t], m1 = m0;
#pragma unroll
        for (int s = 0; s < 4; ++s) if (s <= t) { const float w = wsm[((size_t)g * 128 + t) * 128 + s]; m0 += w * vn[s][0]; m1 += w * vn[s][1]; }
        const unsigned uu = *(const unsigned*)(ub + (size_t)(R0 + t) * 1024 + col);
        *(unsigned*)(um + (size_t)(R0 + t) * 1024 + col) = pk_bf16(bf_lo(uu) * m0, bf_hi(uu) * m1);
    }
    __syncthreads();
}

__device__ __forceinline__ void index_load_A(bf16x8 (&A)[4][4], const bf16_t* QI, int rowbase, int qa) {
    const int lane = fresh_lane();
    const int rr = lane & 31, hi = lane >> 5, blk = rr >> 2;
    const int qit = (blk >> 2) + 2 * (blk & 1), head = 4 * ((blk >> 1) & 1) + (rr & 3);
#pragma unroll
    for (int rt = 0; rt < 4; ++rt) {
        const bf16_t* qp = QI + (size_t)(rowbase + qa + 4 * rt + qit) * 512 + head * 64 + 8 * hi;
#pragma unroll
        for (int ks = 0; ks < 4; ++ks) A[rt][ks] = *(const bf16x8*)(qp + 16 * ks);
    }
}
__device__ __forceinline__ void index_prompt(LDSP unsigned* sc, const LDSP f32x4* wtab  , const bf16x8 (&A)[4][4], const bf16_t* KI, int rowbase, int qa, int nkt, int wid, int lane_unused) {
    const int lane = fresh_lane();
    const int rr = lane & 31, hi = lane >> 5;
    const LDSP f32x4* wl = wtab + 4 * hi;
    bf16x8 Ba[4], Bb[4];
#define IP_LOAD(Bx, kt_) do { const int ktc_ = (kt_) < nkt ? (kt_) : 0; const bf16_t* kp_ = KI + (size_t)(rowbase + 32 * ktc_ + rr) * 64 + 8 * hi; \
        _Pragma("unroll") for (int ks_ = 0; ks_ < 4; ++ks_) Bx[ks_] = *(const bf16x8*)(kp_ + 16 * ks_); } while (0)
#define IP_STEP(Bx, kt_) do { const int kt = (kt_); const int key = 32 * kt + rr; \
        bf16x8 B[4]; \
        _Pragma("unroll") for (int ks = 0; ks < 4; ++ks) B[ks] = Bx[ks]; \
        IP_LOAD(Bx, kt + 16); \
        _Pragma("unroll") for (int rt = 0; rt < 4; ++rt) { \
            f32x16 acc; \
            _Pragma("unroll") for (int i = 0; i < 16; ++i) acc[i] = 0.f; \
            _Pragma("unroll") for (int ks = 0; ks < 4; ++ks) acc = MFMA32(A[rt][ks], B[ks], acc); \
            float s0 = 0.f, s1 = 0.f; \
            const f32x4 wa = wl[8 * rt], wb = wl[8 * rt + 1], wc4 = wl[8 * rt + 2], wd = wl[8 * rt + 3]; \
            _Pragma("unroll") for (int h = 0; h < 4; ++h) { s0 = fmaf(wa[h], fmaxf(acc[h], 0.f), s0); s1 = fmaf(wc4[h], fmaxf(acc[8 + h], 0.f), s1); } \
            _Pragma("unroll") for (int h = 0; h < 4; ++h) { s0 = fmaf(wb[h], fmaxf(acc[4 + h], 0.f), s0); s1 = fmaf(wd[h], fmaxf(acc[12 + h], 0.f), s1); } \
            const int ql = 4 * rt + 2 * hi; \
            sc[ql * SCS + key] = (key <= qa + ql) ? fkey(s0) : 0u; \
            sc[(ql + 1) * SCS + key] = (key <= qa + ql + 1) ? fkey(s1) : 0u; \
        } } while (0)
    IP_LOAD(Ba, wid); IP_LOAD(Bb, wid + 8);
#pragma unroll 1
    for (int kt0 = wid; kt0 < nkt; kt0 += 16) {
        IP_STEP(Ba, kt0);
        if (kt0 + 8 < nkt) IP_STEP(Bb, kt0 + 8);
    }
#undef IP_LOAD
#undef IP_STEP
}
__device__ __forceinline__ void index_sample(LDSP unsigned* sc, const bf16_t* QI, const float* WI, const bf16_t* KI, const float* ckidx  , LDSP int* pt, const int* page_table, int tid, int nd, int t0, int wid, int lane) {
    const int rr = lane & 31, hi = lane >> 5, blk = rr >> 2;
    const int qit = (blk >> 2) + 2 * (blk & 1), head = 4 * ((blk >> 1) & 1) + (rr & 3);
    const int qrow = TP + 4 * nd + t0;
    bf16x8 A[4]; float wgt[16];
    const bf16x8 zero8 = {0, 0, 0, 0, 0, 0, 0, 0};
#pragma unroll
    for (int ks = 0; ks < 4; ++ks) A[ks] = (qit < 2) ? *(const bf16x8*)(QI + (size_t)(qrow + (qit & 1)) * 512 + head * 64 + 16 * ks + 8 * hi) : zero8;
#pragma unroll
    for (int qq = 0; qq < 2; ++qq) { const float* wp = WI + (size_t)(qrow + qq) * 8; const f32x4 w0 = *(const f32x4*)wp, w1 = *(const f32x4*)(wp + 4);
#pragma unroll
        for (int h = 0; h < 4; ++h) { wgt[8 * qq + h] = hi ? 0.f : w0[h] * IDXS; wgt[8 * qq + 4 + h] = hi ? 0.f : w1[h] * IDXS; } }
    if (tid < 16) pt[tid] = page_table[nd * 16 + tid];
    __syncthreads();
    f32x4 Bfa[8], Bfb[8];
#define IS_LOAD(Bf, kt_) do { const int page_ = pt[(kt_) >> 2]; const float* kp_ = ckidx + ((size_t)page_ * 128 + ((kt_) & 3) * 32 + rr) * 64 + 8 * hi; \
        _Pragma("unroll") for (int ks_ = 0; ks_ < 4; ++ks_) { Bf[2 * ks_] = *(const f32x4*)(kp_ + 16 * ks_); Bf[2 * ks_ + 1] = *(const f32x4*)(kp_ + 16 * ks_ + 4); } } while (0)
#define IS_STEP(Bf, kt_) do { const int kt = (kt_); \
        bf16x8 B[4]; \
        if (kt < 64) { \
            _Pragma("unroll") for (int ks = 0; ks < 4; ++ks) B[ks] = pack8(Bf[2 * ks][0], Bf[2 * ks][1], Bf[2 * ks][2], Bf[2 * ks][3], Bf[2 * ks + 1][0], Bf[2 * ks + 1][1], Bf[2 * ks + 1][2], Bf[2 * ks + 1][3]); \
            if (kt + 16 < 64) IS_LOAD(Bf, kt + 16); \
        } else { \
            _Pragma("unroll") for (int ks = 0; ks < 4; ++ks) B[ks] = (rr < 4) ? *(const bf16x8*)(KI + (size_t)(TP + 4 * nd + rr) * 64 + 16 * ks + 8 * hi) : zero8; \
        } \
        f32x16 acc; \
        _Pragma("unroll") for (int i = 0; i < 16; ++i) acc[i] = 0.f; \
        _Pragma("unroll") for (int ks = 0; ks < 4; ++ks) acc = MFMA32(A[ks], B[ks], acc); \
        float s0 = 0.f, s1 = 0.f; \
        _Pragma("unroll") for (int h = 0; h < 8; ++h) { s0 = fmaf(wgt[h], fmaxf(acc[h], 0.f), s0); s1 = fmaf(wgt[8 + h], fmaxf(acc[8 + h], 0.f), s1); } \
        const int keypos = 32 * kt + rr; \
        if (hi == 0) { sc[keypos] = (keypos <= SEQ + t0) ? fkey(s0) : 0u; sc[SCS + keypos] = (keypos <= SEQ + t0 + 1) ? fkey(s1) : 0u; } } while (0)
    IS_LOAD(Bfa, wid); IS_LOAD(Bfb, wid + 8);
#pragma unroll 1
    for (int kt0 = wid; kt0 < 65; kt0 += 16) {
        IS_STEP(Bfa, kt0);
        if (kt0 + 8 < 65) IS_STEP(Bfb, kt0 + 8);
    }
#undef IS_LOAD
#undef IS_STEP
}
#define SR_BLOCKS(...) do { \
    _Pragma("unroll") for (int r = 0; r < 9; ++r) { __VA_ARGS__ } \
    if (nk > 576) { _Pragma("unroll") for (int r = 9; r < 17; ++r) { __VA_ARGS__ } \
    if (nk > 1088) { _Pragma("unroll") for (int r = 17; r < 25; ++r) { __VA_ARGS__ } \
    if (nk > 1600) { _Pragma("unroll") for (int r = 25; r < 33; ++r) { __VA_ARGS__ } } } } } while (0)
__device__ __forceinline__ void select_row(const LDSP unsigned* scrow, int nk, int nvalid, LDSP unsigned long long* maskrow, LDSP unsigned* selw  ) {
    const int lane = fresh_lane();
    unsigned k[33];
#pragma unroll
    for (int r = 0; r < 33; ++r) k[r] = 0u;
    SR_BLOCKS( const int idx = 64 * r + lane; k[r] = (idx < nk) ? scrow[idx] : 0u; );
    unsigned Tgt = 0u, Teq = 0u; int need = 0;
    if (nvalid > KTOP) {
        unsigned kmax = 0u, kmin = 0xffffffffu;
        SR_BLOCKS( kmax = k[r] > kmax ? k[r] : kmax; const unsigned t = k[r] ? k[r] : 0xffffffffu; kmin = t < kmin ? t : kmin; );
        kmax = wmax_u_dpp(kmax); kmin = wmin_u_dpp(kmin);
        const float vmin = unkey(kmin), vmax = unkey(kmax); const float span = vmax - vmin; const float scale = span > 0.f ? 255.5f / span : 0.f;
        *(LDSP u32x4*)(selw + 4 * lane) = (u32x4){0u, 0u, 0u, 0u};
        int bn[33];
#pragma unroll
        for (int r = 0; r < 33; ++r) bn[r] = -1;
        SR_BLOCKS( int b = (int)((unkey(k[r]) - vmin) * scale); b = b < 0 ? 0 : (b > 255 ? 255 : b); bn[r] = k[r] ? b : -1;
            if (k[r]) __hip_atomic_fetch_add(selw + b, 1u, __ATOMIC_RELAXED, __HIP_MEMORY_SCOPE_WORKGROUP); );
        asm volatile("s_waitcnt lgkmcnt(0)" ::: "memory");
        const u32x4 h = *(const LDSP u32x4*)(selw + 4 * lane);
        const int c0 = (int)h.x, c1 = c0 + (int)h.y, c2 = c1 + (int)h.z, c3 = c2 + (int)h.w;
        int x = c3;
        x += __builtin_amdgcn_update_dpp(0, x, 0x111, 0xF, 0xF, true); x += __builtin_amdgcn_update_dpp(0, x, 0x112, 0xF, 0xF, true);
        x += __builtin_amdgcn_update_dpp(0, x, 0x114, 0xF, 0xF, true); x += __builtin_amdgcn_update_dpp(0, x, 0x118, 0xF, 0xF, true);
        const int r0 = __builtin_amdgcn_readlane(x, 15), r1 = __builtin_amdgcn_readlane(x, 31), r2 = __builtin_amdgcn_readlane(x, 47);
        x += (lane >= 16 ? r0 : 0) + (lane >= 32 ? r1 : 0) + (lane >= 48 ? r2 : 0);
        const int R = nvalid - KTOP;
        const unsigned long long over = __builtin_amdgcn_ballot_w64(x > R);
        const int ls = (int)__builtin_ctzll(over);
        const int base = x - c3;
        const int j = (base + c0 > R) ? 0 : ((base + c1 > R) ? 1 : ((base + c2 > R) ? 2 : 3));
        const int cle = base + (j == 0 ? c0 : (j == 1 ? c1 : (j == 2 ? c2 : c3)));
        const int bsel = __builtin_amdgcn_readlane(4 * lane + j, ls), cle_s = __builtin_amdgcn_readlane(cle, ls);
        const int above = nvalid - cle_s;
        int needb = KTOP - above;
        int m = 0;
        SR_BLOCKS( const bool inb = bn[r] == bsel; const unsigned long long eb = __builtin_amdgcn_ballot_w64(inb);
            if (eb) {
                const int pos = m + (int)__builtin_amdgcn_mbcnt_hi((unsigned)(eb >> 32), __builtin_amdgcn_mbcnt_lo((unsigned)eb, 0u));
                if (inb && pos < 64) selw[256 + pos] = k[r];
                m += __builtin_popcountll(eb); } );
        if (m <= 64) {
            asm volatile("s_waitcnt lgkmcnt(0)" ::: "memory");
            const unsigned cand = lane < m ? selw[256 + lane] : 0u;
            int gt = 0, eqb = 0;
            for (int q = 0; q < m; ++q) { const unsigned cq = (unsigned)__builtin_amdgcn_readlane((int)cand, q); gt += cq > cand ? 1 : 0; eqb += (cq == cand && q < lane) ? 1 : 0; }
            const unsigned long long hit = __builtin_amdgcn_ballot_w64(lane < m && gt + eqb == needb - 1);
            const int lh = (int)__builtin_ctzll(hit);
            const unsigned Ts = (unsigned)__builtin_amdgcn_readlane((int)cand, lh); const int gts = __builtin_amdgcn_readlane(gt, lh);
            const int neq = __builtin_popcountll(__builtin_amdgcn_ballot_w64(lane < m && cand == Ts));
            const int needeq = needb - gts;
            if (needeq == neq) { Tgt = Ts - 1u; Teq = 0u; need = 0; } else { Tgt = Ts; Teq = Ts; need = needeq; }
        } else {
            unsigned lo = kmin, hi = kmax + 1u; int flo = nvalid, fhi = 0;
            float glo = (float)(flo - KTOP) + 0.5f, ghi = (float)(fhi - KTOP) + 0.5f; int side = 0;
            for (int it = 0; it < 96; ++it) {
                if (flo == KTOP || hi - lo <= 1u) break;
                unsigned mid;
                if (it >= 40) mid = lo + ((hi - lo) >> 1);
                else { const float lv = unkey(lo), hv = unkey(hi - 1u); mid = fkey(lv + (hv - lv) * (glo / (glo - ghi))); }
                mid = mid > hi - 1u ? hi - 1u : mid; mid = mid < lo + 1u ? lo + 1u : mid;
                int c = 0;
#pragma unroll
                for (int r = 0; r < 33; ++r) c += __builtin_popcountll(__builtin_amdgcn_ballot_w64(k[r] >= mid));
                if (c >= KTOP) { lo = mid; flo = c; glo = (float)(c - KTOP) + 0.5f; if (side == 1) ghi *= 0.5f; side = 1; }
                else           { hi = mid; fhi = c; ghi = (float)(c - KTOP) + 0.5f; if (side == 2) glo *= 0.5f; side = 2; }
            }
            if (flo == KTOP) { Tgt = lo - 1u; Teq = 0u; need = 0; } else { Tgt = lo; Teq = lo; need = KTOP - fhi; }
        }
    }
    unsigned long long myw = 0ull;
    if (need == 0) {
        SR_BLOCKS( const unsigned long long bal = __builtin_amdgcn_ballot_w64(k[r] > Tgt); if (lane == r) myw = bal; );
    } else {
        SR_BLOCKS(
            const bool gt = k[r] > Tgt; const bool eq = (need > 0) && (k[r] == Teq);
            const unsigned long long eb = __builtin_amdgcn_ballot_w64(eq);
            const int pre = (int)__builtin_amdgcn_mbcnt_hi((unsigned)(eb >> 32), __builtin_amdgcn_mbcnt_lo((unsigned)eb, 0u));
            const bool take = eq && (pre < need);
            const int ne = __builtin_popcountll(eb); need -= (ne < need ? ne : need);
            const unsigned long long bal = __builtin_amdgcn_ballot_w64(gt || take);
            if (lane == r) myw = bal;
        );
    }
    if (lane < 33) maskrow[lane] = myw;
}

constexpr int AT_KP = 528, AT_VP = 576, AT_KSLOT = 64 * AT_KP, AT_VSLOT = 64 * AT_VP, AT_V0 = 2 * AT_KSLOT;
static_assert(2 * AT_KSLOT + 2 * AT_VSLOT <= R0_BYTES, "attention tiles fit region 0");
__device__ __forceinline__ void attn_qblock(LDSP unsigned char* lds, const LDSP unsigned long long* maskL, const bf16_t* Q, const bf16_t* KB, const bf16_t* VB, bf16_t* O,
                                            int rowbase, int q0, int ntile, int tid_unused, int wid, int lane_unused) {
    const int lane = fresh_lane();
    const int c = lane & 31, hi = lane >> 5, kvh = wid >> 2, posl = 8 * (wid & 3) + (c >> 2), g = c & 3, i16 = lane & 15;
    const size_t qrow = (size_t)(rowbase + q0 + posl);
    bf16x8 Qf[8];
#pragma unroll
    for (int ks = 0; ks < 8; ++ks) Qf[ks] = *(const bf16x8*)(Q + qrow * 1024 + (kvh * 4 + g) * 128 + 16 * ks + 8 * hi);
    f32x16 Oa[4];
#pragma unroll
    for (int dt = 0; dt < 4; ++dt)
#pragma unroll
        for (int i = 0; i < 16; ++i) Oa[dt][i] = 0.f;
    float m_run = -1e30f, l_run = 0.f;
    const int tg = (wid & 3) * 64 + lane;
    const bf16_t* kg = KB + (size_t)rowbase * 256 + (size_t)(tg >> 4) * 256 + kvh * 128 + (tg & 15) * 8;
    const bf16_t* vg = VB + (size_t)rowbase * 256 + (size_t)(tg >> 4) * 256 + kvh * 128 + (tg & 15) * 8;
    const unsigned kdst = (unsigned)((tg >> 4) * AT_KP + kvh * 256 + (tg & 15) * 16), vdst = (unsigned)(AT_V0 + (tg >> 4) * AT_VP + kvh * 256 + (tg & 15) * 16);
    u32x4 ka[4], va[4];
#define AT_LD(KS, VS, tile) do { _Pragma("unroll") for (int i_ = 0; i_ < 4; ++i_) { KS[i_] = *(const u32x4*)(kg + ((size_t)(tile) * 64 + 16 * i_) * 256); VS[i_] = *(const u32x4*)(vg + ((size_t)(tile) * 64 + 16 * i_) * 256); } } while (0)
#define AT_ST(KS, VS, slot) do { _Pragma("unroll") for (int i_ = 0; i_ < 4; ++i_) { *(LDSP u32x4*)(lds + (slot) * AT_KSLOT + kdst + i_ * 16 * AT_KP) = KS[i_]; *(LDSP u32x4*)(lds + (slot) * AT_VSLOT + vdst + i_ * 16 * AT_VP) = VS[i_]; } } while (0)
#define AT_QK(S0_, S1_, slot) do { const LDSP unsigned char* kp_ = lds + (slot) * AT_KSLOT + c * AT_KP + kvh * 256 + hi * 16; \
        _Pragma("unroll") for (int i_ = 0; i_ < 16; ++i_) { S0_[i_] = 0.f; S1_[i_] = 0.f; } \
        _Pragma("unroll") for (int ks_ = 0; ks_ < 8; ++ks_) { const bf16x8 a0_ = *(const LDSP bf16x8*)(kp_ + ks_ * 32), a1_ = *(const LDSP bf16x8*)(kp_ + 32 * AT_KP + ks_ * 32); \
            S0_ = MFMA32(a0_, Qf[ks_], S0_); S1_ = MFMA32(a1_, Qf[ks_], S1_); } } while (0)
    AT_LD(ka, va, 0); AT_ST(ka, va, 0);
    if (ntile > 1) AT_LD(ka, va, 1);
    __syncthreads();
#define AT_BAR() do { asm volatile("s_waitcnt lgkmcnt(0)" ::: "memory"); __builtin_amdgcn_s_barrier(); asm volatile("" ::: "memory"); } while (0)
    f32x16 S0, S1; bf16x8 pf[4];
    if (kvh) { __builtin_amdgcn_s_barrier(); __builtin_amdgcn_s_setprio(1); }
    AT_QK(S0, S1, 0);
    AT_BAR();
#pragma unroll 1
    for (int t = 0; t < ntile; ++t) {
        {
            const unsigned long long mw = maskL[posl * MASK_STRIDE + t];
            const unsigned wlo = (unsigned)mw >> (4 * hi), whi = (unsigned)(mw >> 32) >> (4 * hi);
            float mt = -INFINITY, mu = -INFINITY;
#pragma unroll
            for (int i = 0; i < 16; ++i) { const int bit = (i & 3) + 8 * (i >> 2);
                const unsigned m0 = (unsigned)__builtin_amdgcn_sbfe((int)wlo, bit, 1), m1 = (unsigned)__builtin_amdgcn_sbfe((int)whi, bit, 1);
                S0[i] = __uint_as_float((__float_as_uint(S0[i]) & m0) | (0xff800000u & ~m0)); S1[i] = __uint_as_float((__float_as_uint(S1[i]) & m1) | (0xff800000u & ~m1));
                if (i & 1) asm("v_max3_f32 %0, %1, %2, %3" : "=v"(mu) : "v"(mu), "v"(S0[i]), "v"(S1[i]));
                else       asm("v_max3_f32 %0, %1, %2, %3" : "=v"(mt) : "v"(mt), "v"(S0[i]), "v"(S1[i])); }
            { const float mo = __shfl_xor(fmaxf(mt, mu), 32); asm("v_max3_f32 %0, %1, %2, %3" : "=v"(mt) : "v"(mt), "v"(mu), "v"(mo)); }
            const float m_new = fmaxf(m_run, mt); const float alpha = __builtin_amdgcn_exp2f(m_run - m_new); m_run = m_new;
            if (__builtin_amdgcn_ballot_w64(alpha != 1.0f) != 0ull) {
#pragma unroll
                for (int dt = 0; dt < 4; ++dt)
#pragma unroll
                    for (int i = 0; i < 16; ++i) Oa[dt][i] *= alpha;
            }
            f32x2 ls2 = {0.f, 0.f}; const f32x2 mn2 = {m_new, m_new};
#pragma unroll
            for (int i = 0; i < 16; i += 2) {
                f32x2 a = (f32x2){S0[i], S0[i + 1]} - mn2, b = (f32x2){S1[i], S1[i + 1]} - mn2;
                a[0] = __builtin_amdgcn_exp2f(a[0]); a[1] = __builtin_amdgcn_exp2f(a[1]); b[0] = __builtin_amdgcn_exp2f(b[0]); b[1] = __builtin_amdgcn_exp2f(b[1]);
                S0[i] = a[0]; S0[i + 1] = a[1]; S1[i] = b[0]; S1[i + 1] = b[1];
                ls2 += a; ls2 += b; }
            l_run = l_run * alpha + (ls2[0] + ls2[1]);
            pf[0] = pack8(S0[0], S0[1], S0[2], S0[3], S0[4], S0[5], S0[6], S0[7]); pf[1] = pack8(S0[8], S0[9], S0[10], S0[11], S0[12], S0[13], S0[14], S0[15]);
            pf[2] = pack8(S1[0], S1[1], S1[2], S1[3], S1[4], S1[5], S1[6], S1[7]); pf[3] = pack8(S1[8], S1[9], S1[10], S1[11], S1[12], S1[13], S1[14], S1[15]);
            if (t + 1 < ntile) { AT_ST(ka, va, (t + 1) & 1); if (t + 2 < ntile) AT_LD(ka, va, t + 2); }
            asm volatile("" : "+v"(pf[0]), "+v"(pf[1]), "+v"(pf[2]), "+v"(pf[3]), "+v"(l_run));
        }
        AT_BAR();
        {
            const LDSP unsigned char* kp = lds + ((t + 1) & 1) * AT_KSLOT + c * AT_KP + kvh * 256 + hi * 16;
            const LDSP unsigned char* vp = lds + AT_V0 + (t & 1) * AT_VSLOT + (4 * hi + (i16 >> 2)) * AT_VP + (kvh * 128 + 16 * ((lane >> 4) & 1) + 4 * (i16 & 3)) * 2;
            constexpr int RD_ = 4;
            bf16x8 frg[RD_];
            const f32x16 Z16 = {0.f, 0.f, 0.f, 0.f, 0.f, 0.f, 0.f, 0.f, 0.f, 0.f, 0.f, 0.f, 0.f, 0.f, 0.f, 0.f};
#define AT_RD(f) do { if ((f) >= 16) { frg[(f) % RD_] = *(const LDSP bf16x8*)(kp + ((f) & 1) * 32 * AT_KP + (((f) - 16) >> 1) * 32); } \
                      else { const LDSP unsigned char* vj_ = vp + (16 * ((f) >> 2)) * AT_VP + ((f) & 3) * 64; frg[(f) % RD_] = cat4(vtr(vj_), vtr(vj_ + 8 * AT_VP)); } } while (0)
#define AT_MM(f) do { if ((f) >= 16) { if ((f) & 1) S1 = MFMA32(frg[(f) % RD_], Qf[((f) - 16) >> 1], (f) < 18 ? Z16 : S1); else S0 = MFMA32(frg[(f) % RD_], Qf[((f) - 16) >> 1], (f) < 18 ? Z16 : S0); } \
                      else { Oa[(f) & 3] = MFMA32(frg[(f) % RD_], pf[(f) >> 2], Oa[(f) & 3]); } } while (0)
            const int nf = (t + 1 < ntile) ? 32 : 16;
#pragma unroll
            for (int f = 0; f < RD_; ++f) AT_RD(f);
            __builtin_amdgcn_sched_barrier(0);
#pragma unroll
            for (int f = 0; f < 16; ++f) { AT_MM(f); if (f + RD_ < 16) AT_RD(f + RD_); __builtin_amdgcn_sched_barrier(0); }
            if (nf == 32) {
#pragma unroll
                for (int f = 16; f < 16 + RD_; ++f) AT_RD(f);
                __builtin_amdgcn_sched_barrier(0);
#pragma unroll
                for (int f = 16; f < 32; ++f) { AT_MM(f); if (f + RD_ < 32) AT_RD(f + RD_); __builtin_amdgcn_sched_barrier(0); }
            }
#undef AT_RD
#undef AT_MM
        }
        AT_BAR();
    }
    if (!kvh) __builtin_amdgcn_s_barrier(); else __builtin_amdgcn_s_setprio(0);
#undef AT_LD
#undef AT_ST
#undef AT_QK
#undef AT_BAR
    const float lt = l_run + __shfl_xor(l_run, 32); const float inv = 1.0f / lt;
    bf16_t* op = O + qrow * 1024 + (kvh * 4 + g) * 128 + 4 * hi;
#pragma unroll
    for (int dt = 0; dt < 4; ++dt)
#pragma unroll
        for (int qd = 0; qd < 4; ++qd) { f32x4 v = {Oa[dt][4 * qd] * inv, Oa[dt][4 * qd + 1] * inv, Oa[dt][4 * qd + 2] * inv, Oa[dt][4 * qd + 3] * inv}; st_bf16x4(op + 32 * dt + 8 * qd, v); }
}

__device__ __forceinline__ void dsa_prompt_block(const Ptrs& P, LDSP unsigned char* lds, int n, int qb, int tid, int wid, int lane) {
    const bf16_t* Q = (const bf16_t*)(P.ws + WS_ACT + B_Q); const bf16_t* KB = (const bf16_t*)(P.ws + WS_ACT + B_KB); const bf16_t* VB = (const bf16_t*)(P.ws + WS_ACT + B_VB);
    const bf16_t* QI = (const bf16_t*)(P.ws + WS_ACT + B_QI); const bf16_t* KI = (const bf16_t*)(P.ws + WS_ACT + B_KI); const float* WI = (const float*)(P.ws + WS_ACT + B_WI);
    bf16_t* O = (bf16_t*)(P.ws + WS_ACT + B_O);
    LDSP unsigned* sc = (LDSP unsigned*)lds; LDSP unsigned long long* maskL = (LDSP unsigned long long*)(lds + MASK_OFF);
    const int rowbase = n * SEQ, q0 = 32 * qb, nkt = qb + 1;
    LDSP float* wtab = (LDSP float*)(lds + 16 * SCS * 4);
    bf16x8 Af[4][4];
    index_load_A(Af, QI, rowbase, q0);
    if (tid < 256) wtab[tid] = WI[(size_t)(rowbase + q0) * 8 + tid] * IDXS;
    __syncthreads();
#if defined(MK_PROBE_IDX)
    for (int rep_ = 0; rep_ < 2; ++rep_)
#endif
    for (int sub = 0; sub < 2; ++sub) {
        const int qa = q0 + 16 * sub;
        if (sub == 1) index_load_A(Af, QI, rowbase, qa);
        index_prompt(sc, (const LDSP f32x4*)(wtab + 128 * sub), Af, KI, rowbase, qa, nkt, wid, lane);
        __syncthreads();
#if defined(MK_PROBE_SEL)
        for (int rep2_ = 0; rep2_ < 2; ++rep2_)
#endif
#pragma unroll 1
        for (int rr = 0; rr < 2; ++rr) { const int ql = 2 * wid + rr; select_row(sc + ql * SCS, 32 * nkt, qa + ql + 1, maskL + (16 * sub + ql) * MASK_STRIDE, (LDSP unsigned*)(lds + SEL_OFF) + 320 * wid); }
        __syncthreads();
    }
#if defined(MK_PROBE_ATT)
    attn_qblock(lds, maskL, Q, KB, VB, O, rowbase, q0, (qb >> 1) + 1, tid, wid, lane);
    __syncthreads();
#endif
    attn_qblock(lds, maskL, Q, KB, VB, O, rowbase, q0, (qb >> 1) + 1, tid, wid, lane);
    __syncthreads();
}

__device__ __forceinline__ void dsa_sample_item(const Ptrs& P, LDSP unsigned char* lds, int jB, int nd, int tp, int tid, int wid, int lane) {
    const bf16_t* Q = (const bf16_t*)(P.ws + WS_ACT + B_Q); const bf16_t* QI = (const bf16_t*)(P.ws + WS_ACT + B_QI); const bf16_t* KI = (const bf16_t*)(P.ws + WS_ACT + B_KI);
    const float* WI = (const float*)(P.ws + WS_ACT + B_WI); bf16_t* O = (bf16_t*)(P.ws + WS_ACT + B_O);
    LDSP unsigned* sc = (LDSP unsigned*)lds; LDSP unsigned long long* maskL = (LDSP unsigned long long*)(lds + MASK_OFF);
    LDSP int* list = (LDSP int*)(lds + 17408); LDSP int* pt = (LDSP int*)(lds + 19456);
    LDSP f32x4* sS = (LDSP f32x4*)(lds + 20480); LDSP f32x4* Opart = (LDSP f32x4*)(lds + 36864); LDSP float* ML = (LDSP float*)(lds + 69632);
    const int t0 = 2 * tp;
    index_sample(sc, QI, WI, KI, P.cache_kidx + (size_t)jB * NPOOL * 128 * 64, pt, P.page_table, tid, nd, t0, wid, lane);
    __syncthreads();
    const int ql = wid >> 2, part = wid & 3, t = t0 + ql;
    const int kvh = lane >> 5, l31 = lane & 31;
    const size_t qrow = (size_t)(TP + 4 * nd + t);
    u32x2 qraw[4];
#pragma unroll
    for (int g = 0; g < 4; ++g) qraw[g] = *(const u32x2*)(Q + qrow * 1024 + (kvh * 4 + g) * 128 + 4 * l31);
    asm volatile("" ::: "memory");
    if (wid < 2) {
        select_row(sc + wid * SCS, 65 * 32, SEQ + t0 + wid + 1, maskL + wid * MASK_STRIDE, (LDSP unsigned*)(lds + SEL_OFF) + 320 * wid);
        int base = 0;
        for (int r = 0; r < 33; ++r) { const unsigned long long w = maskL[wid * MASK_STRIDE + r];
            const int pre = (int)__builtin_amdgcn_mbcnt_hi((unsigned)(w >> 32), __builtin_amdgcn_mbcnt_lo((unsigned)w, 0u));
            if ((w >> lane) & 1ull) { const int p = base + pre; if (p < KTOP) list[wid * KTOP + p] = 64 * r + lane; }
            base += __builtin_popcountll(w); }
    }
    __syncthreads();
    f32x4 qv[4];
#pragma unroll
    for (int g = 0; g < 4; ++g) { const u32x2 w = qraw[g]; qv[g] = (f32x4){bf_lo(w.x), bf_hi(w.x), bf_lo(w.y), bf_hi(w.y)}; }
    const int myidx = list[ql * KTOP + 64 * part + lane];
    const float* ck = P.cache_k + (size_t)jB * NPOOL * 128 * 256; const float* cv = P.cache_v + (size_t)jB * NPOOL * 128 * 256;
    const float* nk = P.out + O_NKS + (size_t)jB * TS * 256; const float* nv = P.out + O_NVS + (size_t)jB * TS * 256;
    float mrun[4], lrun[4]; f32x4 oa[4];
#pragma unroll
    for (int g = 0; g < 4; ++g) { mrun[g] = -1e30f; lrun[g] = 0.f; oa[g] = (f32x4){0.f, 0.f, 0.f, 0.f}; }
#define SA_LOAD(kr, vr, b_) do { _Pragma("unroll") for (int j = 0; j < 4; ++j) { const int idx = __builtin_amdgcn_readlane(myidx, 4 * (b_) + j); \
            const bool past = idx < SEQ; const size_t ro = past ? ((size_t)pt[idx >> 7] * 128 + (idx & 127)) * 256 : (size_t)(4 * nd + idx - SEQ) * 256; \
            kr[j] = *(const f32x4*)((past ? ck : nk) + ro + 4 * lane); vr[j] = *(const f32x4*)((past ? cv : nv) + ro + 4 * lane); } } while (0)
#define SA_STEP(kr, vr) do { \
        float sc4[4][4]; \
        _Pragma("unroll") for (int j = 0; j < 4; ++j) \
            _Pragma("unroll") for (int g = 0; g < 4; ++g) { float d = (qv[g][0] * kr[j][0] + qv[g][1] * kr[j][1]) + (qv[g][2] * kr[j][2] + qv[g][3] * kr[j][3]); \
                d += __int_as_float(__builtin_amdgcn_update_dpp(0, __float_as_int(d), 0xB1, 0xF, 0xF, false)); d += __int_as_float(__builtin_amdgcn_update_dpp(0, __float_as_int(d), 0x4E, 0xF, 0xF, false)); \
                d += __int_as_float(__builtin_amdgcn_update_dpp(0, __float_as_int(d), 0x141, 0xF, 0xF, false)); d += __int_as_float(__builtin_amdgcn_update_dpp(0, __float_as_int(d), 0x140, 0xF, 0xF, false)); \
                d += __shfl_xor(d, 16); sc4[j][g] = d; } \
        _Pragma("unroll") for (int g = 0; g < 4; ++g) { \
            const float mb = fmaxf(fmaxf(sc4[0][g], sc4[1][g]), fmaxf(sc4[2][g], sc4[3][g])); \
            const float mn = fmaxf(mrun[g], mb), alpha = __builtin_amdgcn_exp2f(mrun[g] - mn); mrun[g] = mn; \
            float ps = 0.f; f32x4 o = oa[g] * alpha; \
            _Pragma("unroll") for (int j = 0; j < 4; ++j) { const float pj = __builtin_amdgcn_exp2f(sc4[j][g] - mn); ps += pj; o += vr[j] * pj; } \
            oa[g] = o; lrun[g] = lrun[g] * alpha + ps; \
        } } while (0)
    {
        f32x4 kra[4], vra[4], krb[4], vrb[4], krc[4], vrc[4];
        SA_LOAD(kra, vra, 0); SA_LOAD(krb, vrb, 1); SA_LOAD(krc, vrc, 2);
#pragma unroll 1
        for (int b = 0; b < 16; b += 3) {
            SA_STEP(kra, vra); if (b + 3 < 16) SA_LOAD(kra, vra, b + 3);
            if (b + 1 < 16) { SA_STEP(krb, vrb); if (b + 4 < 16) SA_LOAD(krb, vrb, b + 4); }
            if (b + 2 < 16) { SA_STEP(krc, vrc); if (b + 5 < 16) SA_LOAD(krc, vrc, b + 5); }
        }
    }
#undef SA_LOAD
#undef SA_STEP
#pragma unroll
    for (int g = 0; g < 4; ++g) Opart[(wid * 64 + lane) * 4 + g] = oa[g];
    if (l31 == 0) {
#pragma unroll
        for (int g = 0; g < 4; ++g) { ML[((wid * 2 + kvh) * 4 + g) * 2] = mrun[g]; ML[((wid * 2 + kvh) * 4 + g) * 2 + 1] = lrun[g]; }
    }
    __syncthreads();
    if (part == 0) {
        f32x4 acc4[4]; float M[4], L[4];
#pragma unroll
        for (int g = 0; g < 4; ++g) { M[g] = -INFINITY; L[g] = 0.f; acc4[g] = (f32x4){0.f, 0.f, 0.f, 0.f}; }
#pragma unroll
        for (int pp = 0; pp < 4; ++pp)
#pragma unroll
            for (int g = 0; g < 4; ++g) M[g] = fmaxf(M[g], ML[(((ql * 4 + pp) * 2 + kvh) * 4 + g) * 2]);
#pragma unroll
        for (int pp = 0; pp < 4; ++pp)
#pragma unroll
            for (int g = 0; g < 4; ++g) { const float m = ML[(((ql * 4 + pp) * 2 + kvh) * 4 + g) * 2], l = ML[(((ql * 4 + pp) * 2 + kvh) * 4 + g) * 2 + 1];
                const float f = __builtin_amdgcn_exp2f(m - M[g]); L[g] += l * f; acc4[g] += Opart[((ql * 4 + pp) * 64 + lane) * 4 + g] * f; }
#pragma unroll
        for (int g = 0; g < 4; ++g) st_bf16x4(O + qrow * 1024 + (kvh * 4 + g) * 128 + 4 * l31, acc4[g] * (1.0f / L[g]));
    }
    __syncthreads();
}

constexpr int N_PHASES = 22;
struct Args { const void* in[18]; float* out; unsigned char* ws; float invA[16]; float invI[8]; int ph_lo, ph_hi; };
static_assert(sizeof(Args) == 18 * 8 + 8 + 8 + 64 + 32 + 8, "Args has no padding");

__global__ void __launch_bounds__(512, 2) mk_fwd(Args args) {
    extern __shared__ __attribute__((aligned(16))) unsigned char lds_raw[];
    LDSP unsigned char* lds = (LDSP unsigned char*)lds_raw;
    const int wid0 = __builtin_amdgcn_readfirstlane((int)threadIdx.x >> 6);
    int lane, tid, wid;
#define FRESH_TID() do { wid = wid0; asm volatile("" : "+s"(wid)); asm volatile("v_mbcnt_lo_u32_b32 %0, -1, 0\n\tv_mbcnt_hi_u32_b32 %0, -1, %0" : "=v"(lane)); tid = wid * 64 + lane; } while (0)
    FRESH_TID();
    const int G = gridDim.x, bx = blockIdx.x;
    const int vcu = (G % 8 == 0) ? (bx % 8) * (G / 8) + bx / 8 : bx;
    const int NGW = G * 8;
    for (int u = tid; u < (LDS_BYTES - MISC_OFF) / 4; u += 512) ((LDSP unsigned*)(lds + MISC_OFF))[u] = 0u;
    __syncthreads();
    {
#pragma unroll
        for (int k = 0; k < 18; ++k) if (tid == k) *(LDSP unsigned long long*)(lds + MISC_OFF + 256 + 8 * k) = (unsigned long long)args.in[k];
    }
    __syncthreads();
#define LDPTR(k) ((const void*)(((unsigned long long)(unsigned)__builtin_amdgcn_readlane((int)phi_, (k)) << 32) | (unsigned long long)(unsigned)__builtin_amdgcn_readlane((int)plo_, (k))))
#define LOAD_P() Ptrs P; do { const unsigned long long pv_ = *(volatile LDSP unsigned long long*)(lds + MISC_OFF + 256 + 8 * (lane < 18 ? lane : 0)); const unsigned plo_ = (unsigned)pv_, phi_ = (unsigned)(pv_ >> 32); \
    P.xp = (const float*)LDPTR(0); P.xs = (const float*)LDPTR(1); P.cache_k = (const float*)LDPTR(2); P.cache_v = (const float*)LDPTR(3); P.cache_kidx = (const float*)LDPTR(4); \
    P.page_table = (const int*)LDPTR(5); P.norm_mix = (const float*)LDPTR(6); P.norm_ffn = (const float*)LDPTR(7); P.a_w_in = (const float*)LDPTR(8); P.a_v_gain = (const float*)LDPTR(9); \
    P.a_w_s = (const float*)LDPTR(10); P.a_b_s = (const float*)LDPTR(11); P.a_w_out = (const float*)LDPTR(12); P.b_w_in = (const float*)LDPTR(13); P.b_w_out = (const float*)LDPTR(14); \
    P.ffn_w1 = (const float*)LDPTR(15); P.ffn_w2 = (const float*)LDPTR(16); P.norm_final = (const float*)LDPTR(17); P.out = args.out; P.ws = args.ws; } while (0)
    XcdBarrier bar = xcd_barrier_post((unsigned*)(args.ws + WS_CTL) + CW_BAR, (volatile LAS unsigned*)(lds + MISC_OFF + 32));
#define BXL() ({ int b_ = bx; asm volatile("" : "+s"(b_)); b_; })
#if defined(MK_PROBE_BAR)
#define MK_EXTRA_BAR xcd_barrier(b_);
#else
#define MK_EXTRA_BAR
#endif
#ifndef MK_LAST_PHASE
#define MK_LAST_PHASE 21
#endif
#define IN(k) ((k) <= MK_LAST_PHASE)
#define SEAM(k) do { if ((k) + 1 <= MK_LAST_PHASE) { XcdBarrier b_ = bar; asm volatile("" : "+s"(b_.bar), "+s"(b_.x)); xcd_barrier(b_); MK_EXTRA_BAR } } while (0)

    unsigned char* const ws = args.ws;
    bf16_t* xb = (bf16_t*)(ws + WS_XB); float* ssq = (float*)(ws + WS_SSQ);
    bf16_t* act = (bf16_t*)(ws + WS_ACT);

    if (IN(0)) {
        float myinv = 0.f;
#pragma unroll
        for (int k = 0; k < 16; ++k) if (lane == k) myinv = args.invA[k];
#pragma unroll
        for (int k = 0; k < 8; ++k) if (lane == 16 + k) myinv = args.invI[k];
        LOAD_P(); prologue(P, lds, myinv, vcu * 8 + wid, NGW, wid, lane);
#if defined(MK_PROBE_PRO)
        __syncthreads(); prologue(P, lds, myinv, vcu * 8 + wid, NGW, wid, lane);
#endif
    }
    SEAM(0);

    for (int layer = 0; layer < 4; ++layer) {
        const int j = layer >> 1, ph = 1 + 5 * layer;
        if ((layer & 1) == 0) {
            if (IN(ph)) {
                pg8::Gemm g{xb, (const bf16_t*)(ws + WS_WAIN) + (size_t)j * 2048 * D, TP, 2048, D}; pg8::StaticOrder S; S.init(TP, 2048, G, BXL());
                EpiA1 E{ssq, (bf16_t*)(ws + WS_ACT + A_UB), (bf16_t*)(ws + WS_ACT + A_VB), (float*)(ws + WS_X)};
                pg8::gemm_phase<EpiA1, pg8::StaticOrder, true, true>(lds, g, S, E, wid0);
#if defined(MK_PROBE_MIXG)
                __syncthreads(); pg8::gemm_phase<EpiA1, pg8::StaticOrder, true, true>(lds, g, S, E, wid0);
#endif
                { SEpiA1 Es{ssq, (bf16_t*)(ws + WS_ACT + A_UB), (bf16_t*)(ws + WS_ACT + A_VB)}; gemm_small<64, 64, SEpiA1>(lds, g.A, g.Bt, D, TP, 8, 0, 32, Es, ssq, BXL(), G, wid0);
#if (MK_PROBE_SMALL & 1)
                  gemm_small<64, 64, SEpiA1>(lds, g.A, g.Bt, D, TP, 8, 0, 32, Es, ssq, BXL(), G, wid0);
#endif
                }
            }
            SEAM(ph);
            if (IN(ph + 1)) {
                FRESH_TID(); LOAD_P();
#if defined(MK_PROBE_MIX)
                for (int rep4_ = 0; rep4_ < 2; ++rep4_)
#endif
                for (int u = bx; u < 256; u += G) mix_prompt(P, lds, (const float*)(ws + WS_X), j, (u & 7) * 32 + (u >> 3), tid, wid, lane);
                for (int u = bx; u < 128; u += G) mix_sample(P, lds, j, u, tid, wid, lane);
            }
            SEAM(ph + 1);
            if (IN(ph + 2)) {
                pg8::Gemm g{(const bf16_t*)(ws + WS_ACT + A_UM), (const bf16_t*)(ws + WS_WAOUT) + (size_t)j * D * D, TP, D, D}; pg8::StaticOrder S; S.init(TP, D, G, BXL());
                EpiRes E{xb, ssq};
#if defined(MK_PROBE_MIXG)
                { EpiRes Ed{(bf16_t*)(ws + WS_X + 8 * MiB), (float*)(ws + WS_X + 48 * MiB)}; pg8::gemm_phase<EpiRes, pg8::StaticOrder, true, true>(lds, g, S, Ed, wid0); __syncthreads(); }
#endif
                pg8::gemm_phase<EpiRes, pg8::StaticOrder, true, true>(lds, g, S, E, wid0);
                { SEpiRes Es{xb};
#if (MK_PROBE_SMALL & 2)
                  { SEpiRes Ed{(bf16_t*)(ws + WS_X + 8 * MiB)}; gemm_small<32, 64, SEpiRes>(lds, g.A, g.Bt, g.K, TP, 16, 0, 16, Ed, (float*)(ws + WS_X + 48 * MiB), BXL(), G, wid0); }
#endif
                  gemm_small<32, 64, SEpiRes>(lds, g.A, g.Bt, g.K, TP, 16, 0, 16, Es, ssq, BXL(), G, wid0); }
            }
            SEAM(ph + 2);
        } else {
            if (IN(ph)) {
                pg8::Gemm g{xb, (const bf16_t*)(ws + WS_WBIN) + (size_t)j * NBPAD * D, TP, 2048, D}; pg8::StaticOrder S; S.init(TP, 2048, G, BXL());
                EpiB1 E{ws, args.out, j};
                pg8::gemm_phase<EpiB1, pg8::StaticOrder, true, true>(lds, g, S, E, wid0);
#if defined(MK_PROBE_MIXG)
                __syncthreads(); pg8::gemm_phase<EpiB1, pg8::StaticOrder, true, true>(lds, g, S, E, wid0);
#endif
                { SEpiB1 Es{ws, args.out, j};
#if (MK_PROBE_SMALL & 4)
#pragma unroll 1
                  for (int pass = 0; pass < 2; ++pass) { gemm_small<64, 64, SEpiB1>(lds, g.A, g.Bt, D, TP, 8, 0, 32, Es, ssq, BXL(), G, wid0); gemm_small<64, 128, SEpiB1>(lds, g.A, g.Bt, D, 0, T / 64, 2048, 1, Es, ssq, BXL(), G, wid0); }
#else
                  gemm_small<64, 64, SEpiB1>(lds, g.A, g.Bt, D, TP, 8, 0, 32, Es, ssq, BXL(), G, wid0); gemm_small<64, 128, SEpiB1>(lds, g.A, g.Bt, D, 0, T / 64, 2048, 1, Es, ssq, BXL(), G, wid0);
#endif
                }
            }
            SEAM(ph);
            if (IN(ph + 1)) {
                FRESH_TID(); LOAD_P();
                const int sgrp = (BXL() >> 4) % 3;
#pragma unroll 1
                for (int stage = 0; stage < 5; ++stage) {
                    FRESH_TID();
                    if (stage == 1 || stage == 3) {
                        const int pass = stage >> 1;
                        for (int u = bx; u < 256; u += G) { const int n = u & 7, i = u >> 3; dsa_prompt_block(P, lds, n, pass ? 63 - i : i, tid, wid, lane); }
                    } else if ((stage >> 1) == sgrp) {
                        for (int u = bx; u < 256; u += G) dsa_sample_item(P, lds, j, (u & 7) * 16 + (u >> 4), (u >> 3) & 1, tid, wid, lane);
                    }
                }
            }
            SEAM(ph + 1);
            if (IN(ph + 2)) {
                pg8::Gemm g{(const bf16_t*)(ws + WS_ACT + B_O), (const bf16_t*)(ws + WS_WBOUT) + (size_t)j * D * D, TP, D, D}; pg8::StaticOrder S; S.init(TP, D, G, BXL());
                EpiRes E{xb, ssq};
#if defined(MK_PROBE_MIXG)
                { EpiRes Ed{(bf16_t*)(ws + WS_X + 8 * MiB), (float*)(ws + WS_X + 48 * MiB)}; pg8::gemm_phase<EpiRes, pg8::StaticOrder, true, true>(lds, g, S, Ed, wid0); __syncthreads(); }
#endif
                pg8::gemm_phase<EpiRes, pg8::StaticOrder, true, true>(lds, g, S, E, wid0);
                { SEpiRes Es{xb};
#if (MK_PROBE_SMALL & 2)
                  { SEpiRes Ed{(bf16_t*)(ws + WS_X + 8 * MiB)}; gemm_small<32, 64, SEpiRes>(lds, g.A, g.Bt, g.K, TP, 16, 0, 16, Ed, (float*)(ws + WS_X + 48 * MiB), BXL(), G, wid0); }
#endif
                  gemm_small<32, 64, SEpiRes>(lds, g.A, g.Bt, g.K, TP, 16, 0, 16, Es, ssq, BXL(), G, wid0); }
            }
            SEAM(ph + 2);
        }
        if (IN(ph + 3)) {
            pg8::Gemm g{xb, (const bf16_t*)(ws + WS_W1) + (size_t)layer * FF * D, TP, FF, D}; pg8::StaticOrder S; S.init(TP, FF, G, BXL());
            EpiF1 E{ssq, act};
            pg8::gemm_phase<EpiF1, pg8::StaticOrder, true, true>(lds, g, S, E, wid0);
#if defined(MK_PROBE_F1)
            __syncthreads(); pg8::gemm_phase<EpiF1, pg8::StaticOrder, true, true>(lds, g, S, E, wid0);
#endif
            { SEpiF1 Es{ssq, act}; gemm_small<64, 128, SEpiF1>(lds, g.A, g.Bt, D, TP, 8, 0, 32, Es, ssq, BXL(), G, wid0);
#if (MK_PROBE_SMALL & 8)
              gemm_small<64, 128, SEpiF1>(lds, g.A, g.Bt, D, TP, 8, 0, 32, Es, ssq, BXL(), G, wid0);
#endif
            }
        }
        SEAM(ph + 3);
        if (IN(ph + 4)) {
            pg8::Gemm g{act, (const bf16_t*)(ws + WS_W2) + (size_t)layer * D * FF, TP, D, FF}; pg8::StaticOrder S; S.init(TP, D, G, BXL());
            EpiRes E{xb, ssq};
#if defined(MK_PROBE_F2)
            { EpiRes Ed{(bf16_t*)(ws + WS_X), (float*)(ws + WS_X + 40 * MiB)}; pg8::gemm_phase<EpiRes, pg8::StaticOrder, true, true>(lds, g, S, Ed, wid0); __syncthreads(); }
#endif
            pg8::gemm_phase<EpiRes, pg8::StaticOrder, true, true>(lds, g, S, E, wid0);
            { SEpiRes Es{xb};
#if (MK_PROBE_SMALL & 16)
                  { SEpiRes Ed{(bf16_t*)(ws + WS_X + 8 * MiB)}; gemm_small<32, 64, SEpiRes>(lds, g.A, g.Bt, g.K, TP, 16, 0, 16, Ed, (float*)(ws + WS_X + 48 * MiB), BXL(), G, wid0); }
#endif
                  gemm_small<32, 64, SEpiRes>(lds, g.A, g.Bt, g.K, TP, 16, 0, 16, Es, ssq, BXL(), G, wid0); }
        }
        SEAM(ph + 4);
    }
    if (IN(21)) { FRESH_TID(); LOAD_P(); final_norm(P, vcu * 8 + wid, NGW, lane); }
#undef IN
#undef SEAM
#undef FRESH_TID
#undef BXL
#undef LOAD_P
#undef LDPTR
}
}

extern "C" void kernel_launch(void* const* d_in, const int* in_sizes, int n_in, void* d_out, int out_size, void* d_ws, size_t ws_size, hipStream_t stream) {
    static int grid = 0;
    if (grid == 0) {
        if (n_in != 18 || out_size != (int)mk::O_END || ws_size < mk::WS_END) { fprintf(stderr, "kernel_launch: unexpected problem (n_in %d, out %d, ws %zu); nothing launched\n", n_in, out_size, ws_size); grid = -1; return; }
        int dev = 0, cus = 0, per_cu = 0;
        if (hipGetDevice(&dev) != hipSuccess || hipDeviceGetAttribute(&cus, hipDeviceAttributeMultiprocessorCount, dev) != hipSuccess) { grid = -1; return; }
        if (hipFuncSetAttribute((const void*)mk::mk_fwd, hipFuncAttributeMaxDynamicSharedMemorySize, mk::LDS_BYTES) != hipSuccess) { fprintf(stderr, "kernel_launch: hipFuncSetAttribute failed\n"); grid = -1; return; }
        if (hipOccupancyMaxActiveBlocksPerMultiprocessor(&per_cu, (const void*)mk::mk_fwd, 512, mk::LDS_BYTES) != hipSuccess || per_cu < 1)
            fprintf(stderr, "kernel_launch: note: occupancy query reports %d workgroups per CU\n", per_cu);
        (void)hipGetLastError();
        grid = cus;
    }
    if (grid < 0) return;
    if (hipMemsetAsync((char*)d_ws + mk::WS_CTL, 0, mk::CTL_ZERO_BYTES, stream) != hipSuccess) { fprintf(stderr, "kernel_launch: memset failed\n"); return; }
    mk::Args a{};
    for (int i = 0; i < 18; ++i) a.in[i] = d_in[i];
    a.out = (float*)d_out; a.ws = (unsigned char*)d_ws;
    for (int i = 0; i < 16; ++i) a.invA[i] = (float)pow(500000.0, -(double)i / 16.0);
    for (int i = 0; i < 8; ++i) a.invI[i] = (float)pow(500000.0, -(double)i / 8.0);
    a.ph_lo = 0; a.ph_hi = mk::N_PHASES;
    hipLaunchKernelGGL(mk::mk_fwd, dim3(grid), dim3(512), mk::LDS_BYTES, stream, a);
    const hipError_t le = hipPeekAtLastError();
    if (le != hipSuccess) fprintf(stderr, "kernel_launch: launch failed: %s\n", hipGetErrorName(le));
}
```

```cpp
#include <hip/hip_runtime.h>
#include <cstdio>
#include <cstdint>
#include <cmath>
namespace pg8 {
#define PG8_LAS __attribute__((address_space(3)))
typedef unsigned short bf16_t;
typedef short bf16x8 __attribute__((ext_vector_type(8)));
typedef float f32x4 __attribute__((ext_vector_type(4)));
typedef unsigned u32x4 __attribute__((ext_vector_type(4)));
constexpr int BM = 256, BK = 64, HALF = 128, HTB = HALF * BK * 2  , STAGE_BYTES = 8 * HTB, NXCD = 8, WGM = 4;

__host__ __device__ __forceinline__ int lds_byte(int r, int c) { const int st = (r >> 4) * 2 + (c >> 5), rr = r & 15, cc = c & 31, ob = rr * 64 + cc * 2; return st * 1024 + (ob ^ (((ob >> 9) & 1) << 5)); }
__host__ __device__ __forceinline__ void stage_rc(int b, int& R, int& C) { const int st = b / 1024, sb = b % 1024, swz = sb ^ (((sb >> 9) & 1) << 5); R = (st >> 1) * 16 + swz / 64; C = (st & 1) * 32 + (swz % 64) / 2; }
__host__ __device__ __forceinline__ int perm32(int rho) { const int n = rho >> 4, i = rho & 15; return 8 * (i >> 2) + 4 * n + (i & 3); }

struct Unit { int pm, pn; };
struct Gemm { const bf16_t* A; const bf16_t* Bt; int M, N, K; };

struct StaticOrder {
    int nM, nN, nwg, G, c;
    __host__ __device__ void init(int M, int N, int G_, int c_) { nM = M / BM; nN = N / BM; nwg = nM * nN; G = G_; c = c_; }
    __host__ __device__ bool next(int i, Unit& u) const {
        const long L = (long)i * G + c; if (L >= nwg) return false;
        int wgid = (int)L; { const int q = nwg / NXCD, r = nwg % NXCD, xcd = wgid % NXCD, off = wgid / NXCD; wgid = (xcd < r ? xcd * (q + 1) : r * (q + 1) + (xcd - r) * q) + off; }
        const int nig = WGM * nN, gid = wgid / nig, fm = gid * WGM, gsz = (nM - fm) < WGM ? (nM - fm) : WGM;
        u.pm = fm + ((wgid % nig) % gsz); u.pn = (wgid % nig) / gsz; return true;
    }
    __device__ __forceinline__ void a_ready(const Unit&) const {}
    __device__ __forceinline__ void done(const Unit&) const {}
};

__device__ __forceinline__ unsigned cvt_pk_bf16(float lo, float hi) { unsigned r; asm volatile("v_cvt_pk_bf16_f32 %0, %1, %2" : "=v"(r) : "v"(lo), "v"(hi)); return r; }
template <class Epi, class Sched, bool ALIGN_EPI = false, bool SP2 = false>
__device__ __forceinline__ void gemm_phase(PG8_LAS unsigned char* lds, const Gemm g, const Sched& S, const Epi& E, const int wid_in  ) {
    int lane_; asm volatile("v_mbcnt_lo_u32_b32 %0, -1, 0\n\tv_mbcnt_hi_u32_b32 %0, -1, %0" : "=v"(lane_));
    int wid_ = wid_in; asm volatile("" : "+s"(wid_));
    const int wid = wid_, lane = lane_, tid = wid * 64 + lane, wr = wid >> 2, wc = wid & 3, fr = lane & 15, fq = lane >> 4;
    const int K = g.K, nt = K / BK;
    unsigned voffA[2], voffB[2];
#pragma unroll
    for (int i = 0; i < 2; ++i) { int R, C; stage_rc(tid * 16 + i * 8192, R, C); const int Rb = Epi::PERM ? ((R & ~31) + perm32(R & 31)) : R;
        voffA[i] = (unsigned)(R * K + C) * 2u; voffB[i] = (unsigned)(Rb * K + C) * 2u; }
    const size_t kstep = (size_t)(BK * 2);
    const size_t hstep = (size_t)HALF * K * 2;
    const size_t tstep = 2 * hstep;
    const unsigned ldsw = (unsigned)wid * 1024u;
    const int aoff = lds_byte(wr * 64 + fr, fq * 8), boff = lds_byte(wc * 32 + fr, fq * 8);
#define PG8_SA(b, h) (((b) * 2 + (h)) * HTB)
#define PG8_SB(b, h) ((4 + (b) * 2 + (h)) * HTB)
#define PG8_STAGE(bufoff, gbase, voff) do { _Pragma("unroll") for (int _i = 0; _i < 2; ++_i) \
        __builtin_amdgcn_global_load_lds((const unsigned*)((const char*)(gbase) + (voff)[_i]), (PG8_LAS unsigned*)(lds + (bufoff) + ldsw + _i * 8192), 16, 0, 0); } while (0)
#define PG8_LDA(dst, b, h) do { _Pragma("unroll") for (int m = 0; m < 4; ++m) _Pragma("unroll") for (int k = 0; k < 2; ++k) dst[m][k] = *(const PG8_LAS bf16x8*)(lds + PG8_SA(b, h) + aoff + m * 2048 + k * 1024); } while (0)
#define PG8_LDB(dst, b, h) do { _Pragma("unroll") for (int n = 0; n < 2; ++n) _Pragma("unroll") for (int k = 0; k < 2; ++k) dst[n][k] = *(const PG8_LAS bf16x8*)(lds + PG8_SB(b, h) + boff + n * 2048 + k * 1024); } while (0)
#define PG8_MMA(ai, bj, At, Bt) do { __builtin_amdgcn_s_setprio(1); _Pragma("unroll") for (int m = 0; m < 4; ++m) _Pragma("unroll") for (int n = 0; n < 2; ++n) _Pragma("unroll") for (int k = 0; k < 2; ++k) \
        acc[ai][bj][m][n] = __builtin_amdgcn_mfma_f32_16x16x32_bf16(Bt[n][k], At[m][k], acc[ai][bj][m][n], 0, 0, 0); __builtin_amdgcn_s_setprio(0); } while (0)
#define PG8_WAIT_V(n) asm volatile("s_waitcnt vmcnt(" #n ")" ::: "memory")
#define PG8_WAIT_L(n) asm volatile("s_waitcnt lgkmcnt(" #n ")" ::: "memory")
#define PG8_BAR __builtin_amdgcn_s_barrier()
#define PG8_SCHED __builtin_amdgcn_sched_barrier(0)
    Unit cur, nxt; int ui = 0;
    if (!S.next(0, cur)) return;
    f32x4 acc[2][2][4][2];
#pragma unroll
    for (int a = 0; a < 2; ++a)
#pragma unroll
        for (int b = 0; b < 2; ++b)
#pragma unroll
            for (int m = 0; m < 4; ++m)
#pragma unroll
                for (int n = 0; n < 2; ++n) acc[a][b][m][n] = (f32x4){0.f, 0.f, 0.f, 0.f};
    bf16x8 At[4][2], B0[2][2], B1[2][2];
    const char* cA = (const char*)g.A + (size_t)cur.pm * tstep; const char* cB = (const char*)g.Bt + (size_t)cur.pn * tstep;
    S.a_ready(cur);
    if constexpr (SP2) {
        PG8_STAGE(PG8_SB(0, 0), cB, voffB); PG8_STAGE(PG8_SB(0, 1), cB + hstep, voffB); PG8_STAGE(PG8_SA(0, 0), cA, voffA); PG8_STAGE(PG8_SA(0, 1), cA + hstep, voffA);
        if (wr == 1) PG8_BAR;
        PG8_WAIT_V(2); PG8_BAR;
        PG8_STAGE(PG8_SB(1, 0), cB + kstep, voffB); PG8_STAGE(PG8_SA(1, 0), cA + kstep, voffA); PG8_STAGE(PG8_SB(1, 1), cB + hstep + kstep, voffB);
        PG8_WAIT_V(6); PG8_BAR;
    } else {
        PG8_STAGE(PG8_SB(0, 0), cB, voffB); PG8_STAGE(PG8_SA(0, 0), cA, voffA); PG8_STAGE(PG8_SB(0, 1), cB + hstep, voffB); PG8_STAGE(PG8_SA(0, 1), cA + hstep, voffA);
        if (wr == 1) PG8_BAR;
        PG8_WAIT_V(4); PG8_BAR;
        PG8_STAGE(PG8_SB(1, 0), cB + kstep, voffB); PG8_STAGE(PG8_SA(1, 0), cA + kstep, voffA); PG8_STAGE(PG8_SB(1, 1), cB + hstep + kstep, voffB);
        PG8_WAIT_V(6); PG8_BAR;
    }
    for (;;) {
        const bool has_next = S.next(ui + 1, nxt);
        const char* nA = has_next ? (const char*)g.A + (size_t)nxt.pm * tstep : cA; const char* nB = has_next ? (const char*)g.Bt + (size_t)nxt.pn * tstep : cB;
        for (int t = 0; t < nt; t += 2) {
            const bool last = (t == nt - 2);
            const char* a1 = cA + (size_t)(t + 1) * kstep;
            const char* a2 = last ? nA : cA + (size_t)(t + 2) * kstep; const char* b2 = last ? nB : cB + (size_t)(t + 2) * kstep;
            const char* a3 = a2 + kstep; const char* b3 = b2 + kstep;
            if (last && has_next) S.a_ready(nxt);
            if constexpr (SP2) {
            PG8_LDB(B0, 0, 0); PG8_LDB(B1, 0, 1); PG8_SCHED; PG8_LDA(At, 0, 0); PG8_STAGE(PG8_SA(1, 1), a1 + hstep, voffA);
            PG8_WAIT_V(8); PG8_WAIT_L(0); PG8_BAR; PG8_MMA(0, 0, At, B0); PG8_MMA(0, 1, At, B1); PG8_BAR; PG8_SCHED;
            PG8_LDA(At, 0, 1); PG8_STAGE(PG8_SB(0, 0), b2, voffB); PG8_STAGE(PG8_SB(0, 1), b2 + hstep, voffB); PG8_STAGE(PG8_SA(0, 0), a2, voffA);
            PG8_WAIT_V(8); PG8_WAIT_L(0); PG8_BAR; PG8_MMA(1, 0, At, B0); PG8_MMA(1, 1, At, B1); PG8_BAR; PG8_SCHED;
            PG8_LDB(B0, 1, 0); PG8_LDB(B1, 1, 1); PG8_SCHED; PG8_LDA(At, 1, 0); PG8_STAGE(PG8_SA(0, 1), a2 + hstep, voffA);
            PG8_WAIT_V(8); PG8_WAIT_L(0); PG8_BAR; PG8_MMA(0, 0, At, B0); PG8_MMA(0, 1, At, B1); PG8_BAR; PG8_SCHED;
            PG8_LDA(At, 1, 1); PG8_STAGE(PG8_SB(1, 0), b3, voffB); PG8_STAGE(PG8_SB(1, 1), b3 + hstep, voffB); PG8_STAGE(PG8_SA(1, 0), a3, voffA);
            PG8_WAIT_V(8); PG8_WAIT_L(0); PG8_BAR; PG8_MMA(1, 0, At, B0); PG8_MMA(1, 1, At, B1); PG8_BAR; PG8_SCHED;
            } else {
            PG8_LDB(B0, 0, 0); PG8_SCHED; PG8_LDA(At, 0, 0); PG8_STAGE(PG8_SA(1, 1), a1 + hstep, voffA);
            PG8_WAIT_L(8); PG8_BAR; PG8_WAIT_L(0); PG8_MMA(0, 0, At, B0); PG8_BAR; PG8_SCHED;
            PG8_LDB(B1, 0, 1); PG8_STAGE(PG8_SB(0, 0), b2, voffB);
            PG8_BAR; PG8_WAIT_L(0); PG8_MMA(0, 1, At, B1); PG8_BAR;
            PG8_LDA(At, 0, 1); PG8_STAGE(PG8_SA(0, 0), a2, voffA);
            PG8_BAR; PG8_WAIT_L(0); PG8_MMA(1, 0, At, B0); PG8_BAR; PG8_SCHED;
            PG8_STAGE(PG8_SB(0, 1), b2 + hstep, voffB);
            PG8_WAIT_V(6); PG8_BAR; PG8_MMA(1, 1, At, B1); PG8_BAR;
            PG8_LDB(B0, 1, 0); PG8_SCHED; PG8_LDA(At, 1, 0); PG8_STAGE(PG8_SA(0, 1), a2 + hstep, voffA);
            PG8_WAIT_L(8); PG8_BAR; PG8_WAIT_L(0); PG8_MMA(0, 0, At, B0); PG8_BAR; PG8_SCHED;
            PG8_LDB(B1, 1, 1); PG8_STAGE(PG8_SB(1, 0), b3, voffB);
            PG8_BAR; PG8_WAIT_L(0); PG8_MMA(0, 1, At, B1); PG8_BAR;
            PG8_LDA(At, 1, 1); PG8_STAGE(PG8_SA(1, 0), a3, voffA);
            PG8_BAR; PG8_WAIT_L(0); PG8_MMA(1, 0, At, B0); PG8_BAR; PG8_SCHED;
            PG8_STAGE(PG8_SB(1, 1), b3 + hstep, voffB);
            PG8_WAIT_V(6); PG8_BAR; PG8_MMA(1, 1, At, B1); PG8_BAR;
            }
        }
        if constexpr (ALIGN_EPI) { if (wr == 0) PG8_BAR; }
        if constexpr (!Epi::AFTER_DRAIN) { E(acc, cur, wr, wc, fr, fq); S.done(cur); }
        if (!has_next) break;
#pragma unroll
        for (int a = 0; a < 2; ++a)
#pragma unroll
            for (int b = 0; b < 2; ++b)
#pragma unroll
                for (int m = 0; m < 4; ++m)
#pragma unroll
                    for (int n = 0; n < 2; ++n) acc[a][b][m][n] = (f32x4){0.f, 0.f, 0.f, 0.f};
        cur = nxt; cA = nA; cB = nB; ++ui;
        if constexpr (ALIGN_EPI) { if (wr == 1) PG8_BAR; }
    }
    PG8_WAIT_V(0);
    if constexpr (!ALIGN_EPI) { if (wr == 0) PG8_BAR; }
    PG8_BAR;
    if constexpr (Epi::AFTER_DRAIN) { E.fused(acc, cur, wr, wc, fr, fq, lds, wid, lane); S.done(cur); }
#undef PG8_SA
#undef PG8_SB
#undef PG8_STAGE
#undef PG8_LDA
#undef PG8_LDB
#undef PG8_MMA
#undef PG8_WAIT_V
#undef PG8_WAIT_L
#undef PG8_BAR
#undef PG8_SCHED
}
}

#define GAS __attribute__((address_space(1)))
#define LAS __attribute__((address_space(3)))
typedef unsigned short bf16;
typedef unsigned v4u __attribute__((ext_vector_type(4)));
typedef float f32x4 __attribute__((ext_vector_type(4)));
typedef short bf16x8 __attribute__((ext_vector_type(8)));
typedef GAS unsigned gu32;
typedef GAS unsigned long long gu64;
#define RLX_AGENT __ATOMIC_RELAXED, __HIP_MEMORY_SCOPE_AGENT
#define LDS_WAIT() asm volatile("s_waitcnt lgkmcnt(0)" ::: "memory")
#define VM_WAIT() asm volatile("s_waitcnt vmcnt(0)" ::: "memory")
__device__ __forceinline__ unsigned long long rt() { return __builtin_amdgcn_s_memrealtime(); }
__device__ __forceinline__ unsigned f2bf(float f) { unsigned u = __builtin_bit_cast(unsigned, f); return (u + 0x7fffu + ((u >> 16) & 1u)) >> 16; }
__device__ __forceinline__ unsigned pk2(float lo, float hi) { return f2bf(lo) | (f2bf(hi) << 16); }

#define XB_TMO      128
#define XB_XCNT(j)  (256  + 64 * (j))
#define XB_XSUB(j)  (1280 + 64 * (j))
#define XB_XGEN(j)  (2304 + 64 * (j))
#define XB_TOP      3328
#define XB_TOPGEN   3392
#define XCD_BAR_WORDS 3456
#define XB_SPIN_CAP (1u << 18)

__device__ __forceinline__ unsigned xb_ld(unsigned* p)              { return __hip_atomic_load(p, __ATOMIC_RELAXED, __HIP_MEMORY_SCOPE_AGENT); }
__device__ __forceinline__ unsigned xb_add(unsigned* p, unsigned v) { return __hip_atomic_fetch_add(p, v, __ATOMIC_RELAXED, __HIP_MEMORY_SCOPE_AGENT); }
__device__ __forceinline__ unsigned xb_xcc_id() { return (unsigned)__builtin_amdgcn_s_getreg((3 << 11) | 20) & 0xFu; }
#define XB_SPIN(cond, bar) do { unsigned _sp = 0; while (cond) { __builtin_amdgcn_s_sleep(1); \
    if ((++_sp & 255u) == 0u) { if (xb_ld(&(bar)[XB_TMO])) break; if (_sp > XB_SPIN_CAP) { atomicAdd(&(bar)[XB_TMO], 1u); break; } } } } while (0)

struct XcdBarrier {
    unsigned* bar; unsigned x;
    volatile LAS unsigned* st;
};

__device__ __forceinline__ XcdBarrier xcd_barrier_post(unsigned* bar, volatile LAS unsigned* st) {
    XcdBarrier b; b.bar = bar; b.x = xb_xcc_id(); b.st = st;
    if (threadIdx.x == 0) (void)xb_add(&bar[XB_XCNT(b.x)], 1u);
    return b;
}
__device__ __forceinline__ void xcd_barrier_complete(unsigned* bar, unsigned x, unsigned& nloc, unsigned& nx) {
    const unsigned G = gridDim.x * gridDim.y * gridDim.z;
    unsigned sum, cnt, mine, sp = 0u;
    for (;;) {
        sum = 0u; cnt = 0u; mine = 0u;
#pragma unroll
        for (unsigned j = 0; j < 16; ++j) { const unsigned c = xb_ld(&bar[XB_XCNT(j)]); sum += c; cnt += (c > 0u) ? 1u : 0u; mine = (j == x) ? c : mine; }
        if (sum == G) break;
        __builtin_amdgcn_s_sleep(1);
        if ((++sp & 255u) == 0u) { if (xb_ld(&bar[XB_TMO])) break; if (sp > XB_SPIN_CAP) { atomicAdd(&bar[XB_TMO], 1u); break; } }
    }
    nloc = mine > 0u ? mine : 1u; nx = cnt > 0u ? cnt : 1u;
}

__device__ __forceinline__ void xcd_barrier(const XcdBarrier& b) {
    asm volatile("s_waitcnt vmcnt(0)" ::: "memory");
    __syncthreads();
    if (threadIdx.x == 0) {
        unsigned* bar = b.bar;
        __builtin_amdgcn_s_waitcnt(0);
        unsigned nloc = b.st[0], nx = b.st[1];
        if (nloc == 0u) { xcd_barrier_complete(bar, b.x, nloc, nx); b.st[0] = nloc; b.st[1] = nx; }
        const unsigned old = xb_add(&bar[XB_XSUB(b.x)], 1u);
        const unsigned gen = old / nloc;
        if (old + 1u == (gen + 1u) * nloc) {
            __builtin_amdgcn_fence(__ATOMIC_RELEASE, "agent");
            asm volatile("s_waitcnt vmcnt(0)" ::: "memory");
            const unsigned og = xb_add(&bar[XB_TOP], 1u);
            const unsigned tg = og / nx;
            if (og + 1u == (tg + 1u) * nx) xb_add(&bar[XB_TOPGEN], 1u);
            else XB_SPIN(xb_ld(&bar[XB_TOPGEN]) == tg, bar);
            __builtin_amdgcn_fence(__ATOMIC_ACQUIRE, "agent");
            xb_add(&bar[XB_XGEN(b.x)], 1u);
            asm volatile("s_waitcnt vmcnt(0)" ::: "memory");
        } else {
            XB_SPIN(xb_ld(&bar[XB_XGEN(b.x)]) == gen, bar);
            __builtin_amdgcn_fence(__ATOMIC_ACQUIRE, "agent");
            asm volatile("s_waitcnt vmcnt(0)" ::: "memory");
        }
    }
    __syncthreads();
}


namespace mk {
using pg8::bf16_t; using pg8::bf16x8; using pg8::f32x4; using pg8::u32x4; using pg8::Unit;
typedef float f32x16 __attribute__((ext_vector_type(16)));
typedef float f32x2 __attribute__((ext_vector_type(2)));
typedef unsigned u32x2 __attribute__((ext_vector_type(2)));
typedef short s16x4 __attribute__((ext_vector_type(4)));
typedef short v4i16_t __attribute__((ext_vector_type(4)));
#define LDSP __attribute__((address_space(3)))
#define MFMA32(a, b, c) __builtin_amdgcn_mfma_f32_32x32x16_bf16((a), (b), (c), 0, 0, 0)

constexpr int D = 1024, TP = 16384, TS = 512, T = TP + TS, SEQ = 2048, FF = 4096;
constexpr int NBP = 2120, NBPAD = 2304, NPOOL = 2560;
constexpr float EPS = 1e-6f;
constexpr float IDXS = 0.04419417382415922f;
constexpr float QSCALE = 0.08838834764831845f * 1.4426950408889634f;
constexpr int KTOP = 256;

constexpr size_t MiB = 1u << 20;
constexpr size_t WS_CTL = 0, CTL_ZERO_BYTES = 32768;
constexpr size_t WS_ROPEA = 1 * MiB, WS_ROPEI = 1 * MiB + 512 * 1024;
constexpr size_t WS_SSQ = 2 * MiB;
constexpr size_t WS_WAIN = 4 * MiB, WS_WAOUT = 12 * MiB, WS_WBIN = 16 * MiB, WS_WBOUT = 26 * MiB, WS_W1 = 30 * MiB, WS_W2 = 62 * MiB;
constexpr size_t WS_X = 94 * MiB, WS_XB = 160 * MiB, WS_ACT = 194 * MiB, WS_END = 326 * MiB;
constexpr size_t A_UB = 0, A_VB = 33 * MiB, A_UM = 66 * MiB;
constexpr size_t B_Q = 0, B_KB = 33 * MiB, B_VB = 42 * MiB, B_QI = 51 * MiB, B_KI = 68 * MiB, B_WI = 71 * MiB, B_O = 72 * MiB;
constexpr int CW_BAR = 4096;
constexpr size_t O_Y = 0, O_NKP = 17301504, O_NVP = 25690112, O_NKIP = 34078720, O_NKS = 36175872, O_NVS = 36438016, O_NKIS = 36700160, O_CVP = 36765696, O_CVS = 38862848, O_END = 39911424;
constexpr int R0_BYTES = 141312;
constexpr int MASK_OFF = R0_BYTES, MASK_STRIDE = 34;
constexpr int MISC_OFF = MASK_OFF + 32 * MASK_STRIDE * 8;
constexpr int SEL_OFF = MISC_OFF + 2048;
constexpr int LDS_BYTES = SEL_OFF + 8 * 1280;
static_assert(LDS_BYTES <= 163840, "LDS map");
constexpr int SCS = 2112;

__device__ __forceinline__ unsigned pk_bf16(float lo, float hi) {
    typedef float f2_t __attribute__((ext_vector_type(2))); typedef __bf16 b2_t __attribute__((ext_vector_type(2)));
    f2_t v = {lo, hi}; b2_t b = __builtin_convertvector(v, b2_t); return __builtin_bit_cast(unsigned, b);
}
__device__ __forceinline__ float bf_lo(unsigned w) { return __uint_as_float(w << 16); }
__device__ __forceinline__ float bf_hi(unsigned w) { return __uint_as_float(w & 0xffff0000u); }
__device__ __forceinline__ float wsum(float v) {
#pragma unroll
    for (int o = 1; o < 64; o <<= 1) v += __shfl_xor(v, o);
    return v;
}
__device__ __forceinline__ int wsum_i(int v) {
#pragma unroll
    for (int o = 1; o < 64; o <<= 1) v += __shfl_xor(v, o);
    return v;
}
__device__ __forceinline__ float wmax_f(float v) {
#pragma unroll
    for (int o = 1; o < 64; o <<= 1) v = fmaxf(v, __shfl_xor(v, o));
    return v;
}
__device__ __forceinline__ unsigned wmax_u(unsigned v) {
#pragma unroll
    for (int o = 1; o < 64; o <<= 1) { const unsigned t = (unsigned)__shfl_xor((int)v, o); v = t > v ? t : v; }
    return v;
}
__device__ __forceinline__ unsigned wmin_u(unsigned v) {
#pragma unroll
    for (int o = 1; o < 64; o <<= 1) { const unsigned t = (unsigned)__shfl_xor((int)v, o); v = t < v ? t : v; }
    return v;
}
__device__ __forceinline__ unsigned wmax_u_dpp(unsigned v) {
    unsigned t;
    t = (unsigned)__builtin_amdgcn_update_dpp(0, (int)v, 0xB1, 0xF, 0xF, false); v = t > v ? t : v;
    t = (unsigned)__builtin_amdgcn_update_dpp(0, (int)v, 0x4E, 0xF, 0xF, false); v = t > v ? t : v;
    t = (unsigned)__builtin_amdgcn_update_dpp(0, (int)v, 0x141, 0xF, 0xF, false); v = t > v ? t : v;
    t = (unsigned)__builtin_amdgcn_update_dpp(0, (int)v, 0x140, 0xF, 0xF, false); v = t > v ? t : v;
    const unsigned a = (unsigned)__builtin_amdgcn_readlane((int)v, 0), b = (unsigned)__builtin_amdgcn_readlane((int)v, 16), c = (unsigned)__builtin_amdgcn_readlane((int)v, 32), d = (unsigned)__builtin_amdgcn_readlane((int)v, 48);
    const unsigned ab = a > b ? a : b, cd = c > d ? c : d; return ab > cd ? ab : cd;
}
__device__ __forceinline__ unsigned wmin_u_dpp(unsigned v) { return ~wmax_u_dpp(~v); }
__device__ __forceinline__ float wsum_dpp(float v) {
    v += __int_as_float(__builtin_amdgcn_update_dpp(0, __float_as_int(v), 0xB1, 0xF, 0xF, false)); v += __int_as_float(__builtin_amdgcn_update_dpp(0, __float_as_int(v), 0x4E, 0xF, 0xF, false));
    v += __int_as_float(__builtin_amdgcn_update_dpp(0, __float_as_int(v), 0x141, 0xF, 0xF, false)); v += __int_as_float(__builtin_amdgcn_update_dpp(0, __float_as_int(v), 0x140, 0xF, 0xF, false));
    const int i = __float_as_int(v);
    return (__int_as_float(__builtin_amdgcn_readlane(i, 0)) + __int_as_float(__builtin_amdgcn_readlane(i, 16))) + (__int_as_float(__builtin_amdgcn_readlane(i, 32)) + __int_as_float(__builtin_amdgcn_readlane(i, 48)));
}
__device__ __forceinline__ unsigned fkey(float s) { s = s + 0.0f; const unsigned u = __float_as_uint(s); return (u & 0x80000000u) ? ~u : (u | 0x80000000u); }
__device__ __forceinline__ float unkey(unsigned k) { return __uint_as_float((k & 0x80000000u) ? (k ^ 0x80000000u) : ~k); }
__device__ __forceinline__ float rscale(const float* ssq, int row, int fq) {
    const f32x4 p = *(const f32x4*)(ssq + (size_t)row * 16 + 4 * fq);
    float s = (p[0] + p[1]) + (p[2] + p[3]);
    s += __shfl_xor(s, 16); s += __shfl_xor(s, 32);
    return rsqrtf(s * (1.0f / 1024.0f) + EPS);
}
__device__ __forceinline__ void rscale8(const float* ssq, int row0, int fq, float (&r)[8], float mul) {
    f32x4 p[8];
#pragma unroll
    for (int q = 0; q < 8; ++q) p[q] = *(const f32x4*)(ssq + (size_t)(row0 + (q >> 2) * 128 + (q & 3) * 16) * 16 + 4 * fq);
#pragma unroll
    for (int q = 0; q < 8; ++q) { float s = (p[q][0] + p[q][1]) + (p[q][2] + p[q][3]); s += __shfl_xor(s, 16); s += __shfl_xor(s, 32); r[q] = rsqrtf(s * (1.0f / 1024.0f) + EPS) * mul; }
}
__device__ __forceinline__ float gelu_t(float x) {
    const float y = x * (0.7978845608f + 0.0356774081f * x * x);
    const float e = __builtin_amdgcn_exp2f(-2.885390082f * y);
    return x * __builtin_amdgcn_rcpf(1.0f + e);
}
__device__ __forceinline__ void st_bf16x4(bf16_t* p, const f32x4 v) { u32x2 w; w.x = pk_bf16(v[0], v[1]); w.y = pk_bf16(v[2], v[3]); *(u32x2*)p = w; }
__device__ __forceinline__ void st_bf16x8(bf16_t* p, const f32x4 a, const f32x4 b) { u32x4 w; w.x = pk_bf16(a[0], a[1]); w.y = pk_bf16(a[2], a[3]); w.z = pk_bf16(b[0], b[1]); w.w = pk_bf16(b[2], b[3]); *(u32x4*)p = w; }
__device__ __forceinline__ void st_bf16x8_nt(bf16_t* p, const f32x4 a, const f32x4 b) { u32x4 w; w.x = pk_bf16(a[0], a[1]); w.y = pk_bf16(a[2], a[3]); w.z = pk_bf16(b[0], b[1]); w.w = pk_bf16(b[2], b[3]); __builtin_nontemporal_store(w, (u32x4*)p); }
__device__ __forceinline__ s16x4 vtr(const LDSP unsigned char* p) { return __builtin_bit_cast(s16x4, __builtin_amdgcn_ds_read_tr16_b64_v4i16((LDSP v4i16_t*)p)); }
__device__ __forceinline__ bf16x8 cat4(const s16x4 a, const s16x4 b) { return (bf16x8){a[0], a[1], a[2], a[3], b[0], b[1], b[2], b[3]}; }
__device__ __forceinline__ bf16x8 pack8(float a0, float a1, float a2, float a3, float a4, float a5, float a6, float a7) {
    u32x4 w; w.x = pk_bf16(a0, a1); w.y = pk_bf16(a2, a3); w.z = pk_bf16(a4, a5); w.w = pk_bf16(a6, a7); return __builtin_bit_cast(bf16x8, w);
}

__device__ __forceinline__ int fresh_lane() { int l; asm volatile("v_mbcnt_lo_u32_b32 %0, -1, 0\n\tv_mbcnt_hi_u32_b32 %0, -1, %0" : "=v"(l)); return l; }
struct EpiA1 {
    static constexpr bool PERM = true, AFTER_DRAIN = false;
    const float* ssq; bf16_t* ub; bf16_t* vb; float* vstat;
    __device__ __forceinline__ void operator()(const f32x4 (&acc)[2][2][4][2], const Unit& u, int wr, int wc, int fr, int fq) const {
        const bool isv = u.pn >= 4;
        bf16_t* base = (u.pn < 4 ? ub : vb) + (u.pn & 3) * 256 + wc * 32 + 8 * fq;
        const int row0 = u.pm * 256 + wr * 64 + fr;
        float rs[8]; rscale8(ssq, row0, fq, rs, 1.0f);
#pragma unroll
        for (int ai = 0; ai < 2; ++ai)
#pragma unroll
            for (int m = 0; m < 4; ++m) {
                const int row = row0 + ai * 128 + m * 16; const float r = rs[ai * 4 + m];
                bf16_t* rp = base + (size_t)row * 1024; float s1 = 0.f, s2 = 0.f;
#pragma unroll
                for (int bj = 0; bj < 2; ++bj) { f32x4 v0 = acc[ai][bj][m][0] * r, v1 = acc[ai][bj][m][1] * r;
#pragma unroll
                    for (int j = 0; j < 4; ++j) { v0[j] = gelu_t(v0[j]); v1[j] = gelu_t(v1[j]); s1 += v0[j] + v1[j]; s2 += v0[j] * v0[j] + v1[j] * v1[j]; }
                    st_bf16x8(rp + bj * 128, v0, v1); }
                if (isv) { s1 += __shfl_xor(s1, 16); s1 += __shfl_xor(s1, 32); s2 += __shfl_xor(s2, 16); s2 += __shfl_xor(s2, 32);
                    if (fq == 0) *(f32x2*)(vstat + ((size_t)row * 16 + (u.pn - 4) * 4 + wc) * 2) = (f32x2){s1, s2}; }
            }
    }
};
struct EpiF1 {
    static constexpr bool PERM = true, AFTER_DRAIN = false;
    const float* ssq; bf16_t* a;
    __device__ __forceinline__ void operator()(const f32x4 (&acc)[2][2][4][2], const Unit& u, int wr, int wc, int fr, int fq) const {
        bf16_t* base = a + u.pn * 256 + wc * 32 + 8 * fq;
        const int row0 = u.pm * 256 + wr * 64 + fr;
        float rs[8]; rscale8(ssq, row0, fq, rs, 1.0f);
#pragma unroll
        for (int ai = 0; ai < 2; ++ai)
#pragma unroll
            for (int m = 0; m < 4; ++m) {
                const int row = row0 + ai * 128 + m * 16; const float r = rs[ai * 4 + m];
                bf16_t* rp = base + (size_t)row * FF;
#pragma unroll
                for (int bj = 0; bj < 2; ++bj) { f32x4 v0 = acc[ai][bj][m][0] * r, v1 = acc[ai][bj][m][1] * r;
#pragma unroll
                    for (int j = 0; j < 4; ++j) { const float t0 = fmaxf(v0[j], 0.f), t1 = fmaxf(v1[j], 0.f); v0[j] = t0 * t0; v1[j] = t1 * t1; }
                    st_bf16x8(rp + bj * 128, v0, v1); }
            }
    }
};
struct EpiRes {
    static constexpr bool PERM = true, AFTER_DRAIN = false;
    bf16_t* xb; float* ssq;
    __device__ __forceinline__ void operator()(const f32x4 (&acc)[2][2][4][2], const Unit& u, int wr, int wc, int fr, int fq) const {
        const int col0 = u.pn * 256 + wc * 32 + 8 * fq;
        const int row0 = u.pm * 256 + wr * 64 + fr;
        u32x4 xin[2][4][2];
#pragma unroll
        for (int ai = 0; ai < 2; ++ai)
#pragma unroll
            for (int m = 0; m < 4; ++m)
#pragma unroll
                for (int bj = 0; bj < 2; ++bj) xin[ai][m][bj] = *(const u32x4*)(xb + (size_t)(row0 + ai * 128 + m * 16) * 1024 + col0 + bj * 128);
#pragma unroll
        for (int ai = 0; ai < 2; ++ai) {
#pragma unroll
            for (int m = 0; m < 4; ++m) {
                const int row = row0 + ai * 128 + m * 16; float q = 0.f;
                bf16_t* br = xb + (size_t)row * 1024 + col0;
#pragma unroll
                for (int bj = 0; bj < 2; ++bj) { const u32x4 xo = xin[ai][m][bj];
                    const f32x4 x0 = (f32x4){bf_lo(xo.x), bf_hi(xo.x), bf_lo(xo.y), bf_hi(xo.y)} + acc[ai][bj][m][0], x1 = (f32x4){bf_lo(xo.z), bf_hi(xo.z), bf_lo(xo.w), bf_hi(xo.w)} + acc[ai][bj][m][1];
                    st_bf16x8(br + bj * 128, x0, x1);
                    q += ((x0[0] * x0[0] + x0[1] * x0[1]) + (x0[2] * x0[2] + x0[3] * x0[3])) + ((x1[0] * x1[0] + x1[1] * x1[1]) + (x1[2] * x1[2] + x1[3] * x1[3])); }
                q += __shfl_xor(q, 16); q += __shfl_xor(q, 32);
                if (fq == 0) ssq[(size_t)row * 16 + u.pn * 4 + wc] = q;
            }
        }
    }
};
__device__ __forceinline__ void rope_pair(f32x4& v0, f32x4& v1, const f32x4 ca, const f32x4 cb) {
#pragma unroll
    for (int j = 0; j < 4; ++j) { const float c = (j < 2 ? ca : cb)[2 * (j & 1)], s = (j < 2 ? ca : cb)[2 * (j & 1) + 1];
        const float x1 = v0[j], x2 = v1[j]; v0[j] = x1 * c - x2 * s; v1[j] = x2 * c + x1 * s; }
}
__device__ __forceinline__ void rope_idx(f32x4& v0, const float* ropeI, int pos, int fq) {
    const float* cp = ropeI + ((size_t)pos * 8 + 4 * (fq & 1)) * 2;
    const f32x4 ca = *(const f32x4*)cp, cb = *(const f32x4*)(cp + 4);
#pragma unroll
    for (int j = 0; j < 4; ++j) { const float c = (j < 2 ? ca : cb)[2 * (j & 1)], s = (j < 2 ? ca : cb)[2 * (j & 1) + 1];
        const float own = v0[j], oth = __shfl_xor(own, 32);
        v0[j] = (fq < 2) ? own * c - oth * s : own * c + oth * s; }
}
struct EpiB1 {
    static constexpr bool PERM = false, AFTER_DRAIN = false;
    unsigned char* ws; float* out; int jB;
    __device__ __forceinline__ void operator()(const f32x4 (&acc)[2][2][4][2], const Unit& u, int wr, int wc, int fr, int fq) const {
        const int pn = u.pn;
        const int row0 = u.pm * 256 + wr * 64 + fr;
        const float* ssq = (const float*)(ws + WS_SSQ);
        float rs[8]; rscale8(ssq, row0, fq, rs, pn < 4 ? QSCALE : 1.0f);
        if (pn < 4) {
            const float* ropeA = (const float*)(ws + WS_ROPEA); bf16_t* Q = (bf16_t*)(ws + WS_ACT + B_Q);
#pragma unroll
            for (int ai = 0; ai < 2; ++ai)
#pragma unroll
                for (int m = 0; m < 4; ++m) {
                    const int row = row0 + ai * 128 + m * 16; const float r = rs[ai * 4 + m];
                    const int pos = row & (SEQ - 1);
                    f32x4 ca = {0.f, 0.f, 0.f, 0.f}, cb = ca;
                    if (wc == 0) { const float* cp = ropeA + ((size_t)pos * 16 + 4 * fq) * 2; ca = *(const f32x4*)cp; cb = *(const f32x4*)(cp + 4); }
                    bf16_t* rp = Q + (size_t)row * 1024 + pn * 256 + wc * 32 + 4 * fq;
#pragma unroll
                    for (int bj = 0; bj < 2; ++bj) { f32x4 v0 = acc[ai][bj][m][0] * r, v1 = acc[ai][bj][m][1] * r;
                        if (wc == 0) rope_pair(v0, v1, ca, cb);
                        st_bf16x4(rp + bj * 128, v0); st_bf16x4(rp + bj * 128 + 16, v1); }
                }
        } else if (pn < 6) {
            const float* ropeA = (const float*)(ws + WS_ROPEA);
            float* of = out + ((pn == 4) ? O_NKP : O_NVP) + (size_t)jB * TP * 256;
            bf16_t* ob = (bf16_t*)(ws + WS_ACT + ((pn == 4) ? B_KB : B_VB));
            const bool rot = (pn == 4) && (wc == 0);
#pragma unroll
            for (int ai = 0; ai < 2; ++ai)
#pragma unroll
                for (int m = 0; m < 4; ++m) {
                    const int row = row0 + ai * 128 + m * 16; const float r = rs[ai * 4 + m];
                    const int pos = row & (SEQ - 1);
                    f32x4 ca = {0.f, 0.f, 0.f, 0.f}, cb = ca;
                    if (rot) { const float* cp = ropeA + ((size_t)pos * 16 + 4 * fq) * 2; ca = *(const f32x4*)cp; cb = *(const f32x4*)(cp + 4); }
                    float* fp = of + (size_t)row * 256 + wc * 32 + 4 * fq; bf16_t* bp = ob + (size_t)row * 256 + wc * 32 + 4 * fq;
#pragma unroll
                    for (int bj = 0; bj < 2; ++bj) { f32x4 v0 = acc[ai][bj][m][0] * r, v1 = acc[ai][bj][m][1] * r;
                        if (rot) rope_pair(v0, v1, ca, cb);
                        *(f32x4*)(fp + bj * 128) = v0; *(f32x4*)(fp + bj * 128 + 16) = v1;
                        st_bf16x4(bp + bj * 128, v0); st_bf16x4(bp + bj * 128 + 16, v1); }
                }
        } else {
            const float* ropeI = (const float*)(ws + WS_ROPEI); bf16_t* QI = (bf16_t*)(ws + WS_ACT + B_QI);
#pragma unroll
            for (int ai = 0; ai < 2; ++ai)
#pragma unroll
                for (int m = 0; m < 4; ++m) {
                    const int row = row0 + ai * 128 + m * 16; const float r = rs[ai * 4 + m];
                    const int pos = row & (SEQ - 1);
                    bf16_t* rp = QI + (size_t)row * 512 + (pn - 6) * 256 + wc * 32 + 4 * fq;
#pragma unroll
                    for (int bj = 0; bj < 2; ++bj) { f32x4 v0 = acc[ai][bj][m][0] * r, v1 = acc[ai][bj][m][1] * r;
                        if ((wc & 1) == 0) rope_idx(v0, ropeI, pos, fq);
                        st_bf16x4(rp + bj * 128, v0); st_bf16x4(rp + bj * 128 + 16, v1); }
                }
        }
    }
};

__device__ __forceinline__ float rscale_row(const float* ssq, int row, int hi) {
    const float* p = ssq + (size_t)row * 16 + 8 * hi; const f32x4 a = *(const f32x4*)p, b = *(const f32x4*)(p + 4);
    float s = ((a[0] + a[1]) + (a[2] + a[3])) + ((b[0] + b[1]) + (b[2] + b[3]));
    s += __shfl_xor(s, 32);
    return rsqrtf(s * (1.0f / 1024.0f) + EPS);
}
struct SEpiA1 { static constexpr bool SSQ = false; const float* ssq; bf16_t* ub; bf16_t* vb;
    typedef float Pre;
    __device__ __forceinline__ Pre pre(int row, int col0, int hi) const { return rscale_row(ssq, row, hi); }
    __device__ __forceinline__ float operator()(const f32x16& acc, const Pre& r, int row, int col0, int hi) const {
        bf16_t* base = (col0 < 1024 ? ub : vb) + (size_t)row * 1024 + (col0 & 1023) + 4 * hi;
#pragma unroll
        for (int qd = 0; qd < 4; ++qd) { f32x4 v = {gelu_t(acc[4 * qd] * r), gelu_t(acc[4 * qd + 1] * r), gelu_t(acc[4 * qd + 2] * r), gelu_t(acc[4 * qd + 3] * r)}; st_bf16x4(base + 8 * qd, v); }
        return 0.f; } };
struct SEpiF1 { static constexpr bool SSQ = false; const float* ssq; bf16_t* a;
    typedef float Pre;
    __device__ __forceinline__ Pre pre(int row, int col0, int hi) const { return rscale_row(ssq, row, hi); }
    __device__ __forceinline__ float operator()(const f32x16& acc, const Pre& r, int row, int col0, int hi) const {
        bf16_t* base = a + (size_t)row * FF + col0 + 4 * hi;
#pragma unroll
        for (int qd = 0; qd < 4; ++qd) { f32x4 v;
#pragma unroll
            for (int j = 0; j < 4; ++j) { const float t = fmaxf(acc[4 * qd + j] * r, 0.f); v[j] = t * t; }
            st_bf16x4(base + 8 * qd, v); }
        return 0.f; } };
struct SEpiRes { static constexpr bool SSQ = true; bf16_t* xb;
    struct Pre { u32x2 x0, x1, x2, x3; };
    __device__ __forceinline__ Pre pre(int row, int col0, int hi) const { const bf16_t* br = xb + (size_t)row * 1024 + col0 + 4 * hi;
        Pre p; p.x0 = *(const u32x2*)br; p.x1 = *(const u32x2*)(br + 8); p.x2 = *(const u32x2*)(br + 16); p.x3 = *(const u32x2*)(br + 24); return p; }
    __device__ __forceinline__ float operator()(const f32x16& acc, const Pre& pf, int row, int col0, int hi) const {
        bf16_t* br = xb + (size_t)row * 1024 + col0 + 4 * hi; float q = 0.f;
#pragma unroll
        for (int qd = 0; qd < 4; ++qd) { const u32x2 xo = qd == 0 ? pf.x0 : qd == 1 ? pf.x1 : qd == 2 ? pf.x2 : pf.x3; const f32x4 xn = {bf_lo(xo.x) + acc[4 * qd], bf_hi(xo.x) + acc[4 * qd + 1], bf_lo(xo.y) + acc[4 * qd + 2], bf_hi(xo.y) + acc[4 * qd + 3]};
            st_bf16x4(br + 8 * qd, xn); q += (xn[0] * xn[0] + xn[1] * xn[1]) + (xn[2] * xn[2] + xn[3] * xn[3]); }
        q += __shfl_xor(q, 32);
        return q; } };
struct SEpiB1 { static constexpr bool SSQ = false; unsigned char* ws; float* out; int jB;
    typedef float Pre;
    __device__ __forceinline__ Pre pre(int row, int col0, int hi) const { return rscale_row((const float*)(ws + WS_SSQ), row, hi); }
    __device__ __forceinline__ float operator()(const f32x16& acc, const Pre& rpre, int row, int col0, int hi) const {
        const float* ropeA = (const float*)(ws + WS_ROPEA); const float* ropeI = (const float*)(ws + WS_ROPEI);
        const bool samp = row >= TP; const int pos = samp ? SEQ + (row & 3) : (row & (SEQ - 1)), rowo = samp ? row - TP : row;
        float r = rpre;
        float v[16];
        if (col0 < 1024) r *= QSCALE;
#pragma unroll
        for (int i = 0; i < 16; ++i) v[i] = acc[i] * r;
        if (col0 < 1280 && (col0 & 127) == 0) {
#pragma unroll
            for (int qd = 0; qd < 2; ++qd) { const float* cp = ropeA + ((size_t)pos * 16 + 8 * qd + 4 * hi) * 2; const f32x4 ca = *(const f32x4*)cp, cb = *(const f32x4*)(cp + 4);
#pragma unroll
                for (int j = 0; j < 4; ++j) { const float c = (j < 2 ? ca : cb)[2 * (j & 1)], s = (j < 2 ? ca : cb)[2 * (j & 1) + 1];
                    const float x1 = v[4 * qd + j], x2 = v[4 * qd + 8 + j]; v[4 * qd + j] = x1 * c - x2 * s; v[4 * qd + 8 + j] = x2 * c + x1 * s; } }
        } else if (col0 >= 1536 && col0 < 2112 && (col0 & 63) == 0) {
            const float* cp = ropeI + ((size_t)pos * 8 + 4 * hi) * 2; const f32x4 ca = *(const f32x4*)cp, cb = *(const f32x4*)(cp + 4);
#pragma unroll
            for (int j = 0; j < 4; ++j) { const float c = (j < 2 ? ca : cb)[2 * (j & 1)], s = (j < 2 ? ca : cb)[2 * (j & 1) + 1];
                const float x1 = v[j], x2 = v[4 + j]; v[j] = x1 * c - x2 * s; v[4 + j] = x2 * c + x1 * s; }
        }
        if (col0 < 1024) { bf16_t* p = (bf16_t*)(ws + WS_ACT + B_Q) + (size_t)row * 1024 + col0 + 4 * hi;
#pragma unroll
            for (int qd = 0; qd < 4; ++qd) st_bf16x4(p + 8 * qd, (f32x4){v[4 * qd], v[4 * qd + 1], v[4 * qd + 2], v[4 * qd + 3]});
        } else if (col0 < 1536) { const bool isk = col0 < 1280; const int cc = (isk ? col0 - 1024 : col0 - 1280) + 4 * hi;
            float* fp = out + (isk ? O_NKS : O_NVS) + (size_t)jB * TS * 256 + (size_t)rowo * 256 + cc; bf16_t* bp = (bf16_t*)(ws + WS_ACT + (isk ? B_KB : B_VB)) + (size_t)row * 256 + cc;
#pragma unroll
            for (int qd = 0; qd < 4; ++qd) { const f32x4 t = {v[4 * qd], v[4 * qd + 1], v[4 * qd + 2], v[4 * qd + 3]}; *(f32x4*)(fp + 8 * qd) = t; st_bf16x4(bp + 8 * qd, t); }
        } else if (col0 < 2048) { bf16_t* p = (bf16_t*)(ws + WS_ACT + B_QI) + (size_t)row * 512 + (col0 - 1536) + 4 * hi;
#pragma unroll
            for (int qd = 0; qd < 4; ++qd) st_bf16x4(p + 8 * qd, (f32x4){v[4 * qd], v[4 * qd + 1], v[4 * qd + 2], v[4 * qd + 3]});
        } else if (col0 < 2112) { const int cc = col0 - 2048 + 4 * hi;
            float* fp = out + (samp ? O_NKIS + (size_t)jB * TS * 64 : O_NKIP + (size_t)jB * TP * 64) + (size_t)rowo * 64 + cc; bf16_t* bp = (bf16_t*)(ws + WS_ACT + B_KI) + (size_t)row * 64 + cc;
#pragma unroll
            for (int qd = 0; qd < 4; ++qd) { const f32x4 t = {v[4 * qd], v[4 * qd + 1], v[4 * qd + 2], v[4 * qd + 3]}; *(f32x4*)(fp + 8 * qd) = t; st_bf16x4(bp + 8 * qd, t); }
        } else if (col0 == 2112) { *(f32x4*)((float*)(ws + WS_ACT + B_WI) + (size_t)row * 8 + 4 * hi) = (f32x4){v[0], v[1], v[2], v[3]}; }
        return 0.f; } };

template <int TM, int TN, class EpiS, int MODE = 0>
__device__ __forceinline__ void gemm_small(LDSP unsigned char* lds, const bf16_t* A, const bf16_t* Bt, int K, int row_base, int n_rt, int col_base, int n_cg, const EpiS& E, float* ssq, int bx, int G, int wid_in) {
    constexpr int CT = TN / 32, KS = 8 / CT, RT = TM / 32;
    constexpr int KC = 64 * KS;
    constexpr int PITCH = KC * 2 + 16;
    constexpr int QPR = KC / 8;
    constexpr int NPA = TM * QPR, NPIECE = (TM + TN) * QPR, NLD = (NPIECE + 511) / 512;
    constexpr int STAGE = (TM + TN) * PITCH;
    static_assert(2 * STAGE <= R0_BYTES, "small-gemm stages exceed LDS region");
    static_assert(RT * 32768 + TM * CT * 4 <= R0_BYTES, "small-gemm reduce scratch exceeds LDS region");
    int wid = wid_in; asm volatile("" : "+s"(wid));
    const int lane = fresh_lane(); const int c = lane & 31, hi = lane >> 5;
    const int tid = wid * 64 + lane;
    const int ct = wid % CT, ks = wid / CT;
    const int ntile = n_rt * n_cg, nkc = K / KC;
    LDSP f32x16* part = (LDSP f32x16*)lds;
    LDSP float* qs = (LDSP float*)(lds + RT * 32768);
#define GS_OK(i) (NPIECE % 512 == 0 || (i) < NLD - 1 || tid + 512 * (i) < NPIECE)
#define GS_LOAD(slot, kc_) do { _Pragma("unroll") for (int i = 0; i < NLD; ++i) if (GS_OK(i)) pre[slot][i] = *(const u32x4*)(src[i] + (size_t)(kc_) * KC); } while (0)
#define GS_STORE(slot, off) do { _Pragma("unroll") for (int i = 0; i < NLD; ++i) if (GS_OK(i)) *(LDSP u32x4*)(lds + (off) + dst[i]) = pre[slot][i]; } while (0)
#define GS_MMA(off) do { const LDSP unsigned char* sb = lds + (off) + (TM + ct * 32 + c) * PITCH + hi * 16 + ks * 128; const LDSP unsigned char* sa = lds + (off) + c * PITCH + hi * 16 + ks * 128; \
        _Pragma("unroll") for (int s_ = 0; s_ < 4; ++s_) { const bf16x8 wf = *(const LDSP bf16x8*)(sb + s_ * 32); \
            _Pragma("unroll") for (int r_ = 0; r_ < RT; ++r_) acc[r_] = MFMA32(wf, *(const LDSP bf16x8*)(sa + r_ * 32 * PITCH + s_ * 32), acc[r_]); } } while (0)
    for (int t = bx; t < ntile; t += G) {
        int rt = t / n_cg, cg = t - rt * n_cg;
        int row0 = row_base + TM * rt, colb = col_base + cg * TN;
        if (MODE == 1) {
            if (t < TP / TM) { row0 = TM * t; colb = 2048; cg = 0; }
            else { const int u = t - TP / TM; rt = u / 17; cg = u - rt * 17; row0 = TP + TM * rt; colb = cg * TN; }
        }
        const int col0 = colb + ct * 32;
        const bf16_t* src[NLD]; unsigned dst[NLD];
#pragma unroll
        for (int i = 0; i < NLD; ++i) {
            const int p = tid + 512 * i;
            const bool isA = p < NPA;
            const int pp = isA ? p : p - NPA;
            const int r = pp / QPR, q = pp % QPR;
            src[i] = (isA ? A + (size_t)(row0 + r) * K : Bt + (size_t)(colb + r) * K) + q * 8;
            dst[i] = (unsigned)((isA ? r : TM + r) * PITCH + q * 16);
        }
        typename EpiS::Pre epf{}; if (ks < RT) epf = E.pre(row0 + 32 * ks + c, col0, hi);
        u32x4 pre[2][NLD];
        f32x16 acc[RT];
#if defined(MK_PROBE_SK)
#pragma unroll 1
        for (int rep_ = 0; rep_ < 2; ++rep_) {
        asm volatile("" ::: "memory");
#endif
        GS_LOAD(0, 0); GS_LOAD(1, 1);
        GS_STORE(0, 0); GS_LOAD(0, 2);
        __syncthreads();
#pragma unroll
        for (int r = 0; r < RT; ++r)
#pragma unroll
            for (int i = 0; i < 16; ++i) acc[r][i] = 0.f;
        for (int kc = 0; kc < nkc; kc += 2) {
            GS_STORE(1, STAGE); if (kc + 3 < nkc) GS_LOAD(1, kc + 3);
            GS_MMA(0);
            __syncthreads();
            if (kc + 2 < nkc) { GS_STORE(0, 0); if (kc + 4 < nkc) GS_LOAD(0, kc + 4); }
            GS_MMA(STAGE);
            __syncthreads();
        }
#if defined(MK_PROBE_SK)
        }
#endif
        static_assert(KS >= RT && KS > 1, "epilogue deal: one wave per (column slice, row tile)");
#pragma unroll
        for (int r = 0; r < RT; ++r) part[(r * 8 + wid) * 64 + lane] = acc[r];
        __syncthreads();
        float q = 0.f;
        if (ks < RT) {
            f32x16 sum = part[(ks * 8 + ct) * 64 + lane];
#pragma unroll
            for (int s = 1; s < KS; ++s) { const f32x16 o = part[(ks * 8 + s * CT + ct) * 64 + lane];
#pragma unroll
                for (int i = 0; i < 16; ++i) sum[i] += o[i]; }
            q = E(sum, epf, row0 + 32 * ks + c, col0, hi);
        }
        if (EpiS::SSQ) {
            if (ks < RT && hi == 0) qs[ct * TM + 32 * ks + c] = q;
            __syncthreads();
            if (wid == 0 && (RT == 2 || hi == 0)) { float s = 0.f; const int rr = (RT == 2) ? lane : c;
#pragma unroll
                for (int u = 0; u < CT; ++u) s += qs[u * TM + rr];
                ssq[(size_t)(row0 + rr) * 16 + cg] = s; }
        }
        __syncthreads();
    }
#undef GS_OK
#undef GS_LOAD
#undef GS_STORE
#undef GS_MMA
}

__device__ __forceinline__ void transpose_item(const float* W, const float* gain, int K, int N, bf16_t* WT, LDSP float* scr, int item, int nblk, int lane) {
    const int kb = item / nblk, nb = item % nblk, k0 = 64 * kb, n0 = 32 * nb;
    const int nn = n0 + (lane & 31); const bool inb = nn < N;
    float wv[32];
#pragma unroll
    for (int i = 0; i < 32; ++i) { const int kk = 2 * i + (lane >> 5); wv[i] = inb ? W[(size_t)(k0 + kk) * N + nn] : 0.f; }
    if (gain) {
        const float g0 = gain[k0 + lane];
#pragma unroll
        for (int i = 0; i < 32; ++i) wv[i] *= __shfl(g0, 2 * i + (lane >> 5));
    }
#pragma unroll
    for (int i = 0; i < 32; ++i) { const int kk = 2 * i + (lane >> 5); scr[kk * 33 + (lane & 31)] = wv[i]; }
    asm volatile("s_waitcnt lgkmcnt(0)" ::: "memory");
    const int c = lane & 7;
#pragma unroll
    for (int j = 0; j < 4; ++j) { const int n = (lane >> 3) + 8 * j; const LDSP float* s = scr + (8 * c) * 33 + n;
        u32x4 o; o.x = pk_bf16(s[0 * 33], s[1 * 33]); o.y = pk_bf16(s[2 * 33], s[3 * 33]); o.z = pk_bf16(s[4 * 33], s[5 * 33]); o.w = pk_bf16(s[6 * 33], s[7 * 33]);
        *(u32x4*)(WT + (size_t)(n0 + n) * K + k0 + 8 * c) = o; }
    asm volatile("s_waitcnt lgkmcnt(0)" ::: "memory");
}

struct Ptrs {
    const float *xp, *xs, *cache_k, *cache_v, *cache_kidx; const int* page_table;
    const float *norm_mix, *norm_ffn, *a_w_in, *a_v_gain, *a_w_s, *a_b_s, *a_w_out, *b_w_in, *b_w_out, *ffn_w1, *ffn_w2, *norm_final;
    float* out; unsigned char* ws;
};

__device__ __forceinline__ void prologue(const Ptrs& P, LDSP unsigned char* lds, float myinv  , int gw, int NGW, int wid, int lane) {
    LDSP float* scr = (LDSP float*)(lds + wid * 16384);
    constexpr int I_AIN = 16 * 64, I_AOUT = 16 * 32, I_BIN = 16 * 72, I_BOUT = 16 * 32, I_W1 = 16 * 128, I_W2 = 64 * 32;
    constexpr int NITEMS = 2 * (I_AIN + I_AOUT + I_BIN + I_BOUT) + 4 * (I_W1 + I_W2);
    bf16_t* ws_ain = (bf16_t*)(P.ws + WS_WAIN); bf16_t* ws_aout = (bf16_t*)(P.ws + WS_WAOUT); bf16_t* ws_bin = (bf16_t*)(P.ws + WS_WBIN);
    bf16_t* ws_bout = (bf16_t*)(P.ws + WS_WBOUT); bf16_t* ws_w1 = (bf16_t*)(P.ws + WS_W1); bf16_t* ws_w2 = (bf16_t*)(P.ws + WS_W2);
    for (int it = gw; it < NITEMS; it += NGW) {
        int r = it;
        if (r < 2 * I_AIN) { const int j = r / I_AIN; r -= j * I_AIN;
            transpose_item(P.a_w_in + (size_t)j * D * 2048, P.norm_mix + (2 * j) * D, D, 2048, ws_ain + (size_t)j * 2048 * D, scr, r, 64, lane); continue; }
        r -= 2 * I_AIN;
        if (r < 2 * I_AOUT) { const int j = r / I_AOUT; r -= j * I_AOUT;
            transpose_item(P.a_w_out + (size_t)j * D * D, nullptr, D, D, ws_aout + (size_t)j * D * D, scr, r, 32, lane); continue; }
        r -= 2 * I_AOUT;
        if (r < 2 * I_BIN) { const int j = r / I_BIN; r -= j * I_BIN;
            transpose_item(P.b_w_in + (size_t)j * D * NBP, P.norm_mix + (2 * j + 1) * D, D, NBP, ws_bin + (size_t)j * NBPAD * D, scr, r, 72, lane); continue; }
        r -= 2 * I_BIN;
        if (r < 2 * I_BOUT) { const int j = r / I_BOUT; r -= j * I_BOUT;
            transpose_item(P.b_w_out + (size_t)j * D * D, nullptr, D, D, ws_bout + (size_t)j * D * D, scr, r, 32, lane); continue; }
        r -= 2 * I_BOUT;
        if (r < 4 * I_W1) { const int i = r / I_W1; r -= i * I_W1;
            transpose_item(P.ffn_w1 + (size_t)i * D * FF, P.norm_ffn + i * D, D, FF, ws_w1 + (size_t)i * FF * D, scr, r, 128, lane); continue; }
        r -= 4 * I_W1;
        { const int i = r / I_W2; r -= i * I_W2;
            transpose_item(P.ffn_w2 + (size_t)i * FF * D, nullptr, FF, D, ws_w2 + (size_t)i * D * FF, scr, r, 32, lane); }
    }
    bf16_t* xb = (bf16_t*)(P.ws + WS_XB); float* ssq = (float*)(P.ws + WS_SSQ);
    for (int m0 = gw; m0 < T; m0 += 2 * NGW) {
        const int m1 = m0 + NGW; const bool has1 = m1 < T;
        const float* s0 = (m0 < TP) ? P.xp + (size_t)m0 * D : P.xs + (size_t)(m0 - TP) * D;
        const float* s1 = has1 ? ((m1 < TP) ? P.xp + (size_t)m1 * D : P.xs + (size_t)(m1 - TP) * D) : s0;
        f32x4 va[4], vb4[4];
#pragma unroll
        for (int j = 0; j < 4; ++j) { va[j] = *(const f32x4*)(s0 + 256 * j + 4 * lane); vb4[j] = *(const f32x4*)(s1 + 256 * j + 4 * lane); }
#pragma unroll
        for (int rr = 0; rr < 2; ++rr) {
            if (rr == 1 && !has1) break;
            const int m = rr ? m1 : m0;
#pragma unroll
            for (int j = 0; j < 4; ++j) {
                const f32x4 v = rr ? vb4[j] : va[j];
                st_bf16x4(xb + (size_t)m * D + 256 * j + 4 * lane, v);
                float q = (v[0] * v[0] + v[1] * v[1]) + (v[2] * v[2] + v[3] * v[3]);
                q += __shfl_xor(q, 1); q += __shfl_xor(q, 2); q += __shfl_xor(q, 4); q += __shfl_xor(q, 8);
                if ((lane & 15) == 0) ssq[(size_t)m * 16 + 4 * j + (lane >> 4)] = q;
            }
        }
    }
    { bf16_t* wsb = (bf16_t*)(P.ws + WS_X + 4 * MiB);
      for (int e = gw * 64 + lane; e < 2 * 8 * 128 * 16; e += NGW * 64) {
          const int s0 = (e & 15) * 8, t = (e >> 4) & 127;
          const float* src = P.a_w_s + (size_t)(e >> 4) * 128 + s0; const f32x4 a = *(const f32x4*)src, b = *(const f32x4*)(src + 4);
          float w[8] = {a[0], a[1], a[2], a[3], b[0], b[1], b[2], b[3]};
#pragma unroll
          for (int k = 0; k < 8; ++k) if (s0 + k > t) w[k] = 0.f;
          u32x4 o; o.x = pk_bf16(w[0], w[1]); o.y = pk_bf16(w[2], w[3]); o.z = pk_bf16(w[4], w[5]); o.w = pk_bf16(w[6], w[7]);
          *(u32x4*)(wsb + (size_t)(e >> 4) * 128 + s0) = o; } }
    float* ropeA = (float*)(P.ws + WS_ROPEA); float* ropeI = (float*)(P.ws + WS_ROPEI);
    const int gt = gw * 64 + lane, NGT = NGW * 64;
    for (int e = gt; e < 2052 * 24; e += NGT) {
        const int pos = e / 24, i = e % 24;
        const float inv = __shfl(myinv, i);
        const float ang = (float)pos * inv;
        const double a = (double)ang; const double k = rint(a * 0.15915494309189535); const double rr = fma(-k, 6.283185307179586, a);
        const float rf = (float)rr; const float c = cosf(rf), s = sinf(rf);
        float* dst = (i < 16) ? ropeA + ((size_t)pos * 16 + i) * 2 : ropeI + ((size_t)pos * 8 + (i - 16)) * 2;
        dst[0] = c; dst[1] = s;
    }
}

__device__ __forceinline__ void final_norm(const Ptrs& P, int gw, int NGW, int lane) {
    const bf16_t* xb = (const bf16_t*)(P.ws + WS_XB);
    f32x4 gq[4];
#pragma unroll
    for (int j = 0; j < 4; ++j) gq[j] = *(const f32x4*)(P.norm_final + 256 * j + 4 * lane);
    for (int m0 = gw; m0 < T; m0 += 2 * NGW) {
        const int m1 = m0 + NGW; const bool has1 = m1 < T;
        u32x2 w0[4], w1[4];
#pragma unroll
        for (int j = 0; j < 4; ++j) { w0[j] = *(const u32x2*)(xb + (size_t)m0 * D + 256 * j + 4 * lane); w1[j] = has1 ? *(const u32x2*)(xb + (size_t)m1 * D + 256 * j + 4 * lane) : (u32x2){0u, 0u}; }
#pragma unroll
        for (int rr = 0; rr < 2; ++rr) {
            if (rr == 1 && !has1) break;
            const int m = rr ? m1 : m0; f32x4 v[4]; float q = 0.f;
#pragma unroll
            for (int j = 0; j < 4; ++j) { const u32x2 w = rr ? w1[j] : w0[j]; v[j] = (f32x4){bf_lo(w.x), bf_hi(w.x), bf_lo(w.y), bf_hi(w.y)}; q += (v[j][0] * v[j][0] + v[j][1] * v[j][1]) + (v[j][2] * v[j][2] + v[j][3] * v[j][3]); }
            const float r = rsqrtf(wsum_dpp(q) * (1.0f / 1024.0f) + EPS);
#pragma unroll
            for (int j = 0; j < 4; ++j) *(f32x4*)(P.out + O_Y + (size_t)m * D + 256 * j + 4 * lane) = v[j] * r * gq[j];
        }
    }
}

constexpr int MIX_VP = 320;
__device__ __forceinline__ void mix_prompt(const Ptrs& P, LDSP unsigned char* lds, const float* vstat, int jA, int unit, int tid, int wid, int lane) {
    const int n = unit >> 5, c = (unit >> 1) & 15, hf = unit & 1; const int R0 = n * SEQ + c * 128;
    const bf16_t* ub = (const bf16_t*)(P.ws + WS_ACT + A_UB); const bf16_t* vb = (const bf16_t*)(P.ws + WS_ACT + A_VB); bf16_t* um = (bf16_t*)(P.ws + WS_ACT + A_UM);
    const float* gain = P.a_v_gain + jA * D; const float* wsm = P.a_w_s + (size_t)jA * 8 * 128 * 128; const float* bsm = P.a_b_s + jA * 8 * 128;
    LDSP float* st = (LDSP float*)(lds + 128 * MIX_VP);
    { const int s = 16 * wid + (lane & 15); const float* vp4 = vstat + ((size_t)(R0 + s) * 16 + 4 * (lane >> 4)) * 2;
      const f32x4 a = *(const f32x4*)vp4, b = *(const f32x4*)(vp4 + 4);
      float s1 = (a[0] + a[2]) + (b[0] + b[2]), s2 = (a[1] + a[3]) + (b[1] + b[3]);
      s1 += __shfl_xor(s1, 16); s1 += __shfl_xor(s1, 32); s2 += __shfl_xor(s2, 16); s2 += __shfl_xor(s2, 32);
      const float mu = s1 * (1.0f / 1024.0f); const float var = fmaxf(s2 * (1.0f / 1024.0f) - mu * mu, 0.f);
      if (lane < 16) { st[s] = mu; st[128 + s] = rsqrtf(var + EPS); } }
    __syncthreads();
    const int l31 = lane & 31, hi = lane >> 5, i16 = lane & 15;
    const int tt = wid & 3, dh = wid >> 2;
    u32x4 vcur[4], ucur[4], vnxt[4], unxt[4];
#pragma unroll
    for (int k = 0; k < 4; ++k) { const size_t o = (size_t)(R0 + ((tid + 512 * k) >> 4)) * 1024 + (4 * hf) * 128 + (tid & 15) * 8; vcur[k] = *(const u32x4*)(vb + o); ucur[k] = *(const u32x4*)(ub + o); }
#pragma unroll 1
    for (int gg = 0; gg < 4; ++gg) {
        const int g = 4 * hf + gg;
        const int t = 32 * tt + l31; const bf16_t* wrow = (const bf16_t*)(P.ws + WS_X + 4 * MiB) + ((size_t)(jA * 8 + g) * 128 + t) * 128 + 8 * hi;
        const int nks = 2 * tt + 2;
        bf16x8 wq[8];
#pragma unroll
        for (int ks = 0; ks < 8; ++ks) if (ks < nks) wq[ks] = *(const bf16x8*)(wrow + 16 * ks);
        const float* gp = gain + g * 128 + (tid & 15) * 8; const f32x4 g0 = *(const f32x4*)gp, g1 = *(const f32x4*)(gp + 4);
        float biasv[4];
#pragma unroll
        for (int k = 0; k < 4; ++k) biasv[k] = bsm[g * 128 + ((tid + 512 * k) >> 4)];
        if (gg + 1 < 4) {
#pragma unroll
            for (int k = 0; k < 4; ++k) { const size_t o = (size_t)(R0 + ((tid + 512 * k) >> 4)) * 1024 + (g + 1) * 128 + (tid & 15) * 8; vnxt[k] = *(const u32x4*)(vb + o); unxt[k] = *(const u32x4*)(ub + o); }
        }
#pragma unroll
        for (int k = 0; k < 4; ++k) { const int id = tid + 512 * k, s = id >> 4, dc = id & 15;
            const u32x4 a = vcur[k];
            const float mu = st[s], rstd = st[128 + s];
            u32x4 o;
            o.x = pk_bf16((bf_lo(a.x) - mu) * rstd * g0[0], (bf_hi(a.x) - mu) * rstd * g0[1]); o.y = pk_bf16((bf_lo(a.y) - mu) * rstd * g0[2], (bf_hi(a.y) - mu) * rstd * g0[3]);
            o.z = pk_bf16((bf_lo(a.z) - mu) * rstd * g1[0], (bf_hi(a.z) - mu) * rstd * g1[1]); o.w = pk_bf16((bf_lo(a.w) - mu) * rstd * g1[2], (bf_hi(a.w) - mu) * rstd * g1[3]);
            *(LDSP u32x4*)(lds + s * MIX_VP + dc * 16) = o;
            if (c == 15) {
                float* op = P.out + O_CVP + ((size_t)(jA * 8 + n) * 128 + s) * 1024 + g * 128 + dc * 8;
                *(f32x4*)op = (f32x4){(bf_lo(a.x) - mu) * rstd * g0[0], (bf_hi(a.x) - mu) * rstd * g0[1], (bf_lo(a.y) - mu) * rstd * g0[2], (bf_hi(a.y) - mu) * rstd * g0[3]};
                *(f32x4*)(op + 4) = (f32x4){(bf_lo(a.z) - mu) * rstd * g1[0], (bf_hi(a.z) - mu) * rstd * g1[1], (bf_lo(a.w) - mu) * rstd * g1[2], (bf_hi(a.w) - mu) * rstd * g1[3]}; } }
        __syncthreads();
        f32x16 acc0, acc1;
#pragma unroll
        for (int i = 0; i < 16; ++i) { acc0[i] = 0.f; acc1[i] = 0.f; }
        const LDSP unsigned char* vp = lds + (size_t)(8 * hi + (i16 >> 2)) * MIX_VP + (64 * dh + 16 * ((lane >> 4) & 1) + 4 * (i16 & 3)) * 2;
#pragma unroll
        for (int ks = 0; ks < 8; ++ks) if (ks < nks) {
            const bf16x8 bfrag = wq[ks];
            const LDSP unsigned char* vk = vp + (size_t)(16 * ks) * MIX_VP;
            const bf16x8 a0 = cat4(vtr(vk), vtr(vk + 4 * MIX_VP)), a1 = cat4(vtr(vk + 64), vtr(vk + 4 * MIX_VP + 64));
            acc0 = MFMA32(a0, bfrag, acc0); acc1 = MFMA32(a1, bfrag, acc1);
        }
        LDSP float* ot = (LDSP float*)(lds + 49152);
#pragma unroll
        for (int dti = 0; dti < 2; ++dti)
#pragma unroll
            for (int qd = 0; qd < 4; ++qd) { const f32x16& A = dti ? acc1 : acc0;
                *(LDSP f32x4*)(ot + t * 132 + 64 * dh + 32 * dti + 8 * qd + 4 * hi) = (f32x4){A[4 * qd], A[4 * qd + 1], A[4 * qd + 2], A[4 * qd + 3]}; }
        __syncthreads();
#pragma unroll
        for (int k = 0; k < 4; ++k) { const int id = tid + 512 * k, row = id >> 4, dc = id & 15;
            const f32x4 m0 = *(const LDSP f32x4*)(ot + row * 132 + dc * 8), m1 = *(const LDSP f32x4*)(ot + row * 132 + dc * 8 + 4);
            const size_t o = (size_t)(R0 + row) * 1024 + g * 128 + dc * 8;
            const u32x4 uu = ucur[k]; const float bias = biasv[k];
            u32x4 r;
            r.x = pk_bf16(bf_lo(uu.x) * (m0[0] + bias), bf_hi(uu.x) * (m0[1] + bias)); r.y = pk_bf16(bf_lo(uu.y) * (m0[2] + bias), bf_hi(uu.y) * (m0[3] + bias));
            r.z = pk_bf16(bf_lo(uu.z) * (m1[0] + bias), bf_hi(uu.z) * (m1[1] + bias)); r.w = pk_bf16(bf_lo(uu.w) * (m1[2] + bias), bf_hi(uu.w) * (m1[3] + bias));
            *(u32x4*)(um + o) = r; }
#pragma unroll
        for (int k = 0; k < 4; ++k) { vcur[k] = vnxt[k]; ucur[k] = unxt[k]; }
        __syncthreads();
    }
}
__device__ __forceinline__ void mix_sample(const Ptrs& P, LDSP unsigned char* lds, int jA, int nb, int tid, int wid, int lane) {
    const int R0 = TP + 4 * nb;
    const bf16_t* ub = (const bf16_t*)(P.ws + WS_ACT + A_UB); const bf16_t* vb = (const bf16_t*)(P.ws + WS_ACT + A_VB); bf16_t* um = (bf16_t*)(P.ws + WS_ACT + A_UM);
    const float* gain = P.a_v_gain + jA * D; const float* wsm = P.a_w_s + (size_t)jA * 8 * 128 * 128; const float* bsm = P.a_b_s + jA * 8 * 128;
    LDSP float* st = (LDSP float*)lds;
    if (wid < 4) {
        const bf16_t* vr = vb + (size_t)(R0 + wid) * 1024;
        const u32x4 a = *(const u32x4*)(vr + 8 * lane), b = *(const u32x4*)(vr + 512 + 8 * lane);
        float x[16];
#pragma unroll
        for (int k = 0; k < 4; ++k) { x[2 * k] = bf_lo(a[k]); x[2 * k + 1] = bf_hi(a[k]); x[8 + 2 * k] = bf_lo(b[k]); x[8 + 2 * k + 1] = bf_hi(b[k]); }
        float sm = 0.f;
#pragma unroll
        for (int k = 0; k < 16; ++k) sm += x[k];
        const float mu = wsum(sm) * (1.0f / 1024.0f); float sq = 0.f;
#pragma unroll
        for (int k = 0; k < 16; ++k) { const float d = x[k] - mu; sq += d * d; }
        const float rstd = rsqrtf(wsum(sq) * (1.0f / 1024.0f) + EPS);
        if (lane == 0) { st[wid] = mu; st[4 + wid] = rstd; }
    }
    __syncthreads();
    const int col = 2 * tid, g = col >> 7;
    float vn[4][2];
#pragma unroll
    for (int s = 0; s < 4; ++s) { const unsigned w = *(const unsigned*)(vb + (size_t)(R0 + s) * 1024 + col); const float mu = st[s], rstd = st[4 + s];
        vn[s][0] = (bf_lo(w) - mu) * rstd * gain[col]; vn[s][1] = (bf_hi(w) - mu) * rstd * gain[col + 1];
        *(f32x2*)(P.out + O_CVS + ((size_t)(jA * 128 + nb) * 4 + s) * 1024 + col) = (f32x2){vn[s][0], vn[s][1]}; }
#pragma unroll
    for (int t = 0; t < 4; ++t) {
        float m0 = bsm[g * 128 + t], m1 = m0;
#pragma unroll
        for (int s = 0; s < 4; ++s) if (s <= t) { const float w = wsm[((size_t)g * 128 + t) * 128 + s]; m0 += w * vn[s][0]; m1 += w * vn[s][1]; }
        const unsigned uu = *(const unsigned*)(ub + (size_t)(R0 + t) * 1024 + col);
        *(unsigned*)(um + (size_t)(R0 + t) * 1024 + col) = pk_bf16(bf_lo(uu) * m0, bf_hi(uu) * m1);
    }
    __syncthreads();
}

__device__ __forceinline__ void index_load_A(bf16x8 (&A)[4][4], const bf16_t* QI, int rowbase, int qa) {
    const int lane = fresh_lane();
    const int rr = lane & 31, hi = lane >> 5, blk = rr >> 2;
    const int qit = (blk >> 2) + 2 * (blk & 1), head = 4 * ((blk >> 1) & 1) + (rr & 3);
#pragma unroll
    for (int rt = 0; rt < 4; ++rt) {
        const bf16_t* qp = QI + (size_t)(rowbase + qa + 4 * rt + qit) * 512 + head * 64 + 8 * hi;
#pragma unroll
        for (int ks = 0; ks < 4; ++ks) A[rt][ks] = *(const bf16x8*)(qp + 16 * ks);
    }
}
__device__ __forceinline__ void index_prompt(LDSP unsigned* sc, const LDSP f32x4* wtab  , const bf16x8 (&A)[4][4], const bf16_t* KI, int rowbase, int qa, int nkt, int wid, int lane_unused) {
    const int lane = fresh_lane();
    const int rr = lane & 31, hi = lane >> 5;
    const LDSP f32x4* wl = wtab + 4 * hi;
    bf16x8 Ba[4], Bb[4];
#define IP_LOAD(Bx, kt_) do { const int ktc_ = (kt_) < nkt ? (kt_) : 0; const bf16_t* kp_ = KI + (size_t)(rowbase + 32 * ktc_ + rr) * 64 + 8 * hi; \
        _Pragma("unroll") for (int ks_ = 0; ks_ < 4; ++ks_) Bx[ks_] = *(const bf16x8*)(kp_ + 16 * ks_); } while (0)
#define IP_STEP(Bx, kt_) do { const int kt = (kt_); const int key = 32 * kt + rr; \
        bf16x8 B[4]; \
        _Pragma("unroll") for (int ks = 0; ks < 4; ++ks) B[ks] = Bx[ks]; \
        IP_LOAD(Bx, kt + 16); \
        _Pragma("unroll") for (int rt = 0; rt < 4; ++rt) { \
            f32x16 acc; \
            _Pragma("unroll") for (int i = 0; i < 16; ++i) acc[i] = 0.f; \
            _Pragma("unroll") for (int ks = 0; ks < 4; ++ks) acc = MFMA32(A[rt][ks], B[ks], acc); \
            float s0 = 0.f, s1 = 0.f; \
            const f32x4 wa = wl[8 * rt], wb = wl[8 * rt + 1], wc4 = wl[8 * rt + 2], wd = wl[8 * rt + 3]; \
            _Pragma("unroll") for (int h = 0; h < 4; ++h) { s0 = fmaf(wa[h], fmaxf(acc[h], 0.f), s0); s1 = fmaf(wc4[h], fmaxf(acc[8 + h], 0.f), s1); } \
            _Pragma("unroll") for (int h = 0; h < 4; ++h) { s0 = fmaf(wb[h], fmaxf(acc[4 + h], 0.f), s0); s1 = fmaf(wd[h], fmaxf(acc[12 + h], 0.f), s1); } \
            const int ql = 4 * rt + 2 * hi; \
            sc[ql * SCS + key] = (key <= qa + ql) ? fkey(s0) : 0u; \
            sc[(ql + 1) * SCS + key] = (key <= qa + ql + 1) ? fkey(s1) : 0u; \
        } } while (0)
    IP_LOAD(Ba, wid); IP_LOAD(Bb, wid + 8);
#pragma unroll 1
    for (int kt0 = wid; kt0 < nkt; kt0 += 16) {
        IP_STEP(Ba, kt0);
        if (kt0 + 8 < nkt) IP_STEP(Bb, kt0 + 8);
    }
#undef IP_LOAD
#undef IP_STEP
}
__device__ __forceinline__ void index_sample(LDSP unsigned* sc, const bf16_t* QI, const float* WI, const bf16_t* KI, const float* ckidx  , LDSP int* pt, const int* page_table, int tid, int nd, int t0, int wid, int lane) {
    const int rr = lane & 31, hi = lane >> 5, blk = rr >> 2;
    const int qit = (blk >> 2) + 2 * (blk & 1), head = 4 * ((blk >> 1) & 1) + (rr & 3);
    const int qrow = TP + 4 * nd + t0;
    bf16x8 A[4]; float wgt[16];
    const bf16x8 zero8 = {0, 0, 0, 0, 0, 0, 0, 0};
#pragma unroll
    for (int ks = 0; ks < 4; ++ks) A[ks] = (qit < 2) ? *(const bf16x8*)(QI + (size_t)(qrow + (qit & 1)) * 512 + head * 64 + 16 * ks + 8 * hi) : zero8;
#pragma unroll
    for (int qq = 0; qq < 2; ++qq) { const float* wp = WI + (size_t)(qrow + qq) * 8; const f32x4 w0 = *(const f32x4*)wp, w1 = *(const f32x4*)(wp + 4);
#pragma unroll
        for (int h = 0; h < 4; ++h) { wgt[8 * qq + h] = hi ? 0.f : w0[h] * IDXS; wgt[8 * qq + 4 + h] = hi ? 0.f : w1[h] * IDXS; } }
    if (tid < 16) pt[tid] = page_table[nd * 16 + tid];
    __syncthreads();
    f32x4 Bfa[8], Bfb[8];
#define IS_LOAD(Bf, kt_) do { const int page_ = pt[(kt_) >> 2]; const float* kp_ = ckidx + ((size_t)page_ * 128 + ((kt_) & 3) * 32 + rr) * 64 + 8 * hi; \
        _Pragma("unroll") for (int ks_ = 0; ks_ < 4; ++ks_) { Bf[2 * ks_] = *(const f32x4*)(kp_ + 16 * ks_); Bf[2 * ks_ + 1] = *(const f32x4*)(kp_ + 16 * ks_ + 4); } } while (0)
#define IS_STEP(Bf, kt_) do { const int kt = (kt_); \
        bf16x8 B[4]; \
        if (kt < 64) { \
            _Pragma("unroll") for (int ks = 0; ks < 4; ++ks) B[ks] = pack8(Bf[2 * ks][0], Bf[2 * ks][1], Bf[2 * ks][2], Bf[2 * ks][3], Bf[2 * ks + 1][0], Bf[2 * ks + 1][1], Bf[2 * ks + 1][2], Bf[2 * ks + 1][3]); \
            if (kt + 16 < 64) IS_LOAD(Bf, kt + 16); \
        } else { \
            _Pragma("unroll") for (int ks = 0; ks < 4; ++ks) B[ks] = (rr < 4) ? *(const bf16x8*)(KI + (size_t)(TP + 4 * nd + rr) * 64 + 16 * ks + 8 * hi) : zero8; \
        } \
        f32x16 acc; \
        _Pragma("unroll") for (int i = 0; i < 16; ++i) acc[i] = 0.f; \
        _Pragma("unroll") for (int ks = 0; ks < 4; ++ks) acc = MFMA32(A[ks], B[ks], acc); \
        float s0 = 0.f, s1 = 0.f; \
        _Pragma("unroll") for (int h = 0; h < 8; ++h) { s0 = fmaf(wgt[h], fmaxf(acc[h], 0.f), s0); s1 = fmaf(wgt[8 + h], fmaxf(acc[8 + h], 0.f), s1); } \
        const int keypos = 32 * kt + rr; \
        if (hi == 0) { sc[keypos] = (keypos <= SEQ + t0) ? fkey(s0) : 0u; sc[SCS + keypos] = (keypos <= SEQ + t0 + 1) ? fkey(s1) : 0u; } } while (0)
    IS_LOAD(Bfa, wid); IS_LOAD(Bfb, wid + 8);
#pragma unroll 1
    for (int kt0 = wid; kt0 < 65; kt0 += 16) {
        IS_STEP(Bfa, kt0);
        if (kt0 + 8 < 65) IS_STEP(Bfb, kt0 + 8);
    }
#undef IS_LOAD
#undef IS_STEP
}
#define SR_BLOCKS(...) do { \
    _Pragma("unroll") for (int r = 0; r < 9; ++r) { __VA_ARGS__ } \
    if (nk > 576) { _Pragma("unroll") for (int r = 9; r < 17; ++r) { __VA_ARGS__ } \
    if (nk > 1088) { _Pragma("unroll") for (int r = 17; r < 25; ++r) { __VA_ARGS__ } \
    if (nk > 1600) { _Pragma("unroll") for (int r = 25; r < 33; ++r) { __VA_ARGS__ } } } } } while (0)
__device__ __forceinline__ void select_row(const LDSP unsigned* scrow, int nk, int nvalid, LDSP unsigned long long* maskrow, LDSP unsigned* selw  ) {
    const int lane = fresh_lane();
    unsigned k[33];
#pragma unroll
    for (int r = 0; r < 33; ++r) k[r] = 0u;
    SR_BLOCKS( const int idx = 64 * r + lane; k[r] = (idx < nk) ? scrow[idx] : 0u; );
    unsigned Tgt = 0u, Teq = 0u; int need = 0;
    if (nvalid > KTOP) {
        unsigned kmax = 0u, kmin = 0xffffffffu;
        SR_BLOCKS( kmax = k[r] > kmax ? k[r] : kmax; const unsigned t = k[r] ? k[r] : 0xffffffffu; kmin = t < kmin ? t : kmin; );
        kmax = wmax_u_dpp(kmax); kmin = wmin_u_dpp(kmin);
        const float vmin = unkey(kmin), vmax = unkey(kmax); const float span = vmax - vmin; const float scale = span > 0.f ? 255.5f / span : 0.f;
        *(LDSP u32x4*)(selw + 4 * lane) = (u32x4){0u, 0u, 0u, 0u};
        int bn[33];
#pragma unroll
        for (int r = 0; r < 33; ++r) bn[r] = -1;
        SR_BLOCKS( int b = (int)((unkey(k[r]) - vmin) * scale); b = b < 0 ? 0 : (b > 255 ? 255 : b); bn[r] = k[r] ? b : -1;
            if (k[r]) __hip_atomic_fetch_add(selw + b, 1u, __ATOMIC_RELAXED, __HIP_MEMORY_SCOPE_WORKGROUP); );
        asm volatile("s_waitcnt lgkmcnt(0)" ::: "memory");
        const u32x4 h = *(const LDSP u32x4*)(selw + 4 * lane);
        const int c0 = (int)h.x, c1 = c0 + (int)h.y, c2 = c1 + (int)h.z, c3 = c2 + (int)h.w;
        int x = c3;
        x += __builtin_amdgcn_update_dpp(0, x, 0x111, 0xF, 0xF, true); x += __builtin_amdgcn_update_dpp(0, x, 0x112, 0xF, 0xF, true);
        x += __builtin_amdgcn_update_dpp(0, x, 0x114, 0xF, 0xF, true); x += __builtin_amdgcn_update_dpp(0, x, 0x118, 0xF, 0xF, true);
        const int r0 = __builtin_amdgcn_readlane(x, 15), r1 = __builtin_amdgcn_readlane(x, 31), r2 = __builtin_amdgcn_readlane(x, 47);
        x += (lane >= 16 ? r0 : 0) + (lane >= 32 ? r1 : 0) + (lane >= 48 ? r2 : 0);
        const int R = nvalid - KTOP;
        const unsigned long long over = __builtin_amdgcn_ballot_w64(x > R);
        const int ls = (int)__builtin_ctzll(over);
        const int base = x - c3;
        const int j = (base + c0 > R) ? 0 : ((base + c1 > R) ? 1 : ((base + c2 > R) ? 2 : 3));
        const int cle = base + (j == 0 ? c0 : (j == 1 ? c1 : (j == 2 ? c2 : c3)));
        const int bsel = __builtin_amdgcn_readlane(4 * lane + j, ls), cle_s = __builtin_amdgcn_readlane(cle, ls);
        const int above = nvalid - cle_s;
        int needb = KTOP - above;
        int m = 0;
        SR_BLOCKS( const bool inb = bn[r] == bsel; const unsigned long long eb = __builtin_amdgcn_ballot_w64(inb);
            if (eb) {
                const int pos = m + (int)__builtin_amdgcn_mbcnt_hi((unsigned)(eb >> 32), __builtin_amdgcn_mbcnt_lo((unsigned)eb, 0u));
                if (inb && pos < 64) selw[256 + pos] = k[r];
                m += __builtin_popcountll(eb); } );
        if (m <= 64) {
            asm volatile("s_waitcnt lgkmcnt(0)" ::: "memory");
            const unsigned cand = lane < m ? selw[256 + lane] : 0u;
            int gt = 0, eqb = 0;
            for (int q = 0; q < m; ++q) { const unsigned cq = (unsigned)__builtin_amdgcn_readlane((int)cand, q); gt += cq > cand ? 1 : 0; eqb += (cq == cand && q < lane) ? 1 : 0; }
            const unsigned long long hit = __builtin_amdgcn_ballot_w64(lane < m && gt + eqb == needb - 1);
            const int lh = (int)__builtin_ctzll(hit);
            const unsigned Ts = (unsigned)__builtin_amdgcn_readlane((int)cand, lh); const int gts = __builtin_amdgcn_readlane(gt, lh);
            const int neq = __builtin_popcountll(__builtin_amdgcn_ballot_w64(lane < m && cand == Ts));
            const int needeq = needb - gts;
            if (needeq == neq) { Tgt = Ts - 1u; Teq = 0u; need = 0; } else { Tgt = Ts; Teq = Ts; need = needeq; }
        } else {
            unsigned lo = kmin, hi = kmax + 1u; int flo = nvalid, fhi = 0;
            float glo = (float)(flo - KTOP) + 0.5f, ghi = (float)(fhi - KTOP) + 0.5f; int side = 0;
            for (int it = 0; it < 96; ++it) {
                if (flo == KTOP || hi - lo <= 1u) break;
                unsigned mid;
                if (it >= 40) mid = lo + ((hi - lo) >> 1);
                else { const float lv = unkey(lo), hv = unkey(hi - 1u); mid = fkey(lv + (hv - lv) * (glo / (glo - ghi))); }
                mid = mid > hi - 1u ? hi - 1u : mid; mid = mid < lo + 1u ? lo + 1u : mid;
                int c = 0;
#pragma unroll
                for (int r = 0; r < 33; ++r) c += __builtin_popcountll(__builtin_amdgcn_ballot_w64(k[r] >= mid));
                if (c >= KTOP) { lo = mid; flo = c; glo = (float)(c - KTOP) + 0.5f; if (side == 1) ghi *= 0.5f; side = 1; }
                else           { hi = mid; fhi = c; ghi = (float)(c - KTOP) + 0.5f; if (side == 2) glo *= 0.5f; side = 2; }
            }
            if (flo == KTOP) { Tgt = lo - 1u; Teq = 0u; need = 0; } else { Tgt = lo; Teq = lo; need = KTOP - fhi; }
        }
    }
    unsigned long long myw = 0ull;
    if (need == 0) {
        SR_BLOCKS( const unsigned long long bal = __builtin_amdgcn_ballot_w64(k[r] > Tgt); if (lane == r) myw = bal; );
    } else {
        SR_BLOCKS(
            const bool gt = k[r] > Tgt; const bool eq = (need > 0) && (k[r] == Teq);
            const unsigned long long eb = __builtin_amdgcn_ballot_w64(eq);
            const int pre = (int)__builtin_amdgcn_mbcnt_hi((unsigned)(eb >> 32), __builtin_amdgcn_mbcnt_lo((unsigned)eb, 0u));
            const bool take = eq && (pre < need);
            const int ne = __builtin_popcountll(eb); need -= (ne < need ? ne : need);
            const unsigned long long bal = __builtin_amdgcn_ballot_w64(gt || take);
            if (lane == r) myw = bal;
        );
    }
    if (lane < 33) maskrow[lane] = myw;
}

constexpr int AT_KP = 528, AT_VP = 576, AT_KSLOT = 64 * AT_KP, AT_VSLOT = 64 * AT_VP, AT_V0 = 2 * AT_KSLOT;
static_assert(2 * AT_KSLOT + 2 * AT_VSLOT <= R0_BYTES, "attention tiles fit region 0");
__device__ __forceinline__ void attn_qblock(LDSP unsigned char* lds, const LDSP unsigned long long* maskL, const bf16_t* Q, const bf16_t* KB, const bf16_t* VB, bf16_t* O,
                                            int rowbase, int q0, int ntile, int tid_unused, int wid, int lane_unused) {
    const int lane = fresh_lane();
    const int c = lane & 31, hi = lane >> 5, kvh = wid >> 2, posl = 8 * (wid & 3) + (c >> 2), g = c & 3, i16 = lane & 15;
    const size_t qrow = (size_t)(rowbase + q0 + posl);
    bf16x8 Qf[8];
#pragma unroll
    for (int ks = 0; ks < 8; ++ks) Qf[ks] = *(const bf16x8*)(Q + qrow * 1024 + (kvh * 4 + g) * 128 + 16 * ks + 8 * hi);
    f32x16 Oa[4];
#pragma unroll
    for (int dt = 0; dt < 4; ++dt)
#pragma unroll
        for (int i = 0; i < 16; ++i) Oa[dt][i] = 0.f;
    float m_run = -1e30f, l_run = 0.f;
    const int tg = (wid & 3) * 64 + lane;
    const bf16_t* kg = KB + (size_t)rowbase * 256 + (size_t)(tg >> 4) * 256 + kvh * 128 + (tg & 15) * 8;
    const bf16_t* vg = VB + (size_t)rowbase * 256 + (size_t)(tg >> 4) * 256 + kvh * 128 + (tg & 15) * 8;
    const unsigned kdst = (unsigned)((tg >> 4) * AT_KP + kvh * 256 + (tg & 15) * 16), vdst = (unsigned)(AT_V0 + (tg >> 4) * AT_VP + kvh * 256 + (tg & 15) * 16);
    u32x4 ka[4], va[4];
#define AT_LD(KS, VS, tile) do { _Pragma("unroll") for (int i_ = 0; i_ < 4; ++i_) { KS[i_] = *(const u32x4*)(kg + ((size_t)(tile) * 64 + 16 * i_) * 256); VS[i_] = *(const u32x4*)(vg + ((size_t)(tile) * 64 + 16 * i_) * 256); } } while (0)
#define AT_ST(KS, VS, slot) do { _Pragma("unroll") for (int i_ = 0; i_ < 4; ++i_) { *(LDSP u32x4*)(lds + (slot) * AT_KSLOT + kdst + i_ * 16 * AT_KP) = KS[i_]; *(LDSP u32x4*)(lds + (slot) * AT_VSLOT + vdst + i_ * 16 * AT_VP) = VS[i_]; } } while (0)
#define AT_QK(S0_, S1_, slot) do { const LDSP unsigned char* kp_ = lds + (slot) * AT_KSLOT + c * AT_KP + kvh * 256 + hi * 16; \
        _Pragma("unroll") for (int i_ = 0; i_ < 16; ++i_) { S0_[i_] = 0.f; S1_[i_] = 0.f; } \
        _Pragma("unroll") for (int ks_ = 0; ks_ < 8; ++ks_) { const bf16x8 a0_ = *(const LDSP bf16x8*)(kp_ + ks_ * 32), a1_ = *(const LDSP bf16x8*)(kp_ + 32 * AT_KP + ks_ * 32); \
            S0_ = MFMA32(a0_, Qf[ks_], S0_); S1_ = MFMA32(a1_, Qf[ks_], S1_); } } while (0)
    AT_LD(ka, va, 0); AT_ST(ka, va, 0);
    if (ntile > 1) AT_LD(ka, va, 1);
    __syncthreads();
#define AT_BAR() do { asm volatile("s_waitcnt lgkmcnt(0)" ::: "memory"); __builtin_amdgcn_s_barrier(); asm volatile("" ::: "memory"); } while (0)
    f32x16 S0, S1; bf16x8 pf[4];
    if (kvh) { __builtin_amdgcn_s_barrier(); __builtin_amdgcn_s_setprio(1); }
    AT_QK(S0, S1, 0);
    AT_BAR();
#pragma unroll 1
    for (int t = 0; t < ntile; ++t) {
        {
            const unsigned long long mw = maskL[posl * MASK_STRIDE + t];
            const unsigned wlo = (unsigned)mw >> (4 * hi), whi = (unsigned)(mw >> 32) >> (4 * hi);
            float mt = -INFINITY, mu = -INFINITY;
#pragma unroll
            for (int i = 0; i < 16; ++i) { const int bit = (i & 3) + 8 * (i >> 2);
                const unsigned m0 = (unsigned)__builtin_amdgcn_sbfe((int)wlo, bit, 1), m1 = (unsigned)__builtin_amdgcn_sbfe((int)whi, bit, 1);
                S0[i] = __uint_as_float((__float_as_uint(S0[i]) & m0) | (0xff800000u & ~m0)); S1[i] = __uint_as_float((__float_as_uint(S1[i]) & m1) | (0xff800000u & ~m1));
                if (i & 1) asm("v_max3_f32 %0, %1, %2, %3" : "=v"(mu) : "v"(mu), "v"(S0[i]), "v"(S1[i]));
                else       asm("v_max3_f32 %0, %1, %2, %3" : "=v"(mt) : "v"(mt), "v"(S0[i]), "v"(S1[i])); }
            { const float mo = __shfl_xor(fmaxf(mt, mu), 32); asm("v_max3_f32 %0, %1, %2, %3" : "=v"(mt) : "v"(mt), "v"(mu), "v"(mo)); }
            const float m_new = fmaxf(m_run, mt); const float alpha = __builtin_amdgcn_exp2f(m_run - m_new); m_run = m_new;
            if (__builtin_amdgcn_ballot_w64(alpha != 1.0f) != 0ull) {
#pragma unroll
                for (int dt = 0; dt < 4; ++dt)
#pragma unroll
                    for (int i = 0; i < 16; ++i) Oa[dt][i] *= alpha;
            }
            f32x2 ls2 = {0.f, 0.f}; const f32x2 mn2 = {m_new, m_new};
#pragma unroll
            for (int i = 0; i < 16; i += 2) {
                f32x2 a = (f32x2){S0[i], S0[i + 1]} - mn2, b = (f32x2){S1[i], S1[i + 1]} - mn2;
                a[0] = __builtin_amdgcn_exp2f(a[0]); a[1] = __builtin_amdgcn_exp2f(a[1]); b[0] = __builtin_amdgcn_exp2f(b[0]); b[1] = __builtin_amdgcn_exp2f(b[1]);
                S0[i] = a[0]; S0[i + 1] = a[1]; S1[i] = b[0]; S1[i + 1] = b[1];
                ls2 += a; ls2 += b; }
            l_run = l_run * alpha + (ls2[0] + ls2[1]);
            pf[0] = pack8(S0[0], S0[1], S0[2], S0[3], S0[4], S0[5], S0[6], S0[7]); pf[1] = pack8(S0[8], S0[9], S0[10], S0[11], S0[12], S0[13], S0[14], S0[15]);
            pf[2] = pack8(S1[0], S1[1], S1[2], S1[3], S1[4], S1[5], S1[6], S1[7]); pf[3] = pack8(S1[8], S1[9], S1[10], S1[11], S1[12], S1[13], S1[14], S1[15]);
            if (t + 1 < ntile) { AT_ST(ka, va, (t + 1) & 1); if (t + 2 < ntile) AT_LD(ka, va, t + 2); }
            asm volatile("" : "+v"(pf[0]), "+v"(pf[1]), "+v"(pf[2]), "+v"(pf[3]), "+v"(l_run));
        }
        AT_BAR();
        {
            const LDSP unsigned char* kp = lds + ((t + 1) & 1) * AT_KSLOT + c * AT_KP + kvh * 256 + hi * 16;
            const LDSP unsigned char* vp = lds + AT_V0 + (t & 1) * AT_VSLOT + (4 * hi + (i16 >> 2)) * AT_VP + (kvh * 128 + 16 * ((lane >> 4) & 1) + 4 * (i16 & 3)) * 2;
            constexpr int RD_ = 4;
            bf16x8 frg[RD_];
            const f32x16 Z16 = {0.f, 0.f, 0.f, 0.f, 0.f, 0.f, 0.f, 0.f, 0.f, 0.f, 0.f, 0.f, 0.f, 0.f, 0.f, 0.f};
#define AT_RD(f) do { if ((f) >= 16) { frg[(f) % RD_] = *(const LDSP bf16x8*)(kp + ((f) & 1) * 32 * AT_KP + (((f) - 16) >> 1) * 32); } \
                      else { const LDSP unsigned char* vj_ = vp + (16 * ((f) >> 2)) * AT_VP + ((f) & 3) * 64; frg[(f) % RD_] = cat4(vtr(vj_), vtr(vj_ + 8 * AT_VP)); } } while (0)
#define AT_MM(f) do { if ((f) >= 16) { if ((f) & 1) S1 = MFMA32(frg[(f) % RD_], Qf[((f) - 16) >> 1], (f) < 18 ? Z16 : S1); else S0 = MFMA32(frg[(f) % RD_], Qf[((f) - 16) >> 1], (f) < 18 ? Z16 : S0); } \
                      else { Oa[(f) & 3] = MFMA32(frg[(f) % RD_], pf[(f) >> 2], Oa[(f) & 3]); } } while (0)
            const int nf = (t + 1 < ntile) ? 32 : 16;
#pragma unroll
            for (int f = 0; f < RD_; ++f) AT_RD(f);
            __builtin_amdgcn_sched_barrier(0);
#pragma unroll
            for (int f = 0; f < 16; ++f) { AT_MM(f); if (f + RD_ < 16) AT_RD(f + RD_); __builtin_amdgcn_sched_barrier(0); }
            if (nf == 32) {
#pragma unroll
                for (int f = 16; f < 16 + RD_; ++f) AT_RD(f);
                __builtin_amdgcn_sched_barrier(0);
#pragma unroll
                for (int f = 16; f < 32; ++f) { AT_MM(f); if (f + RD_ < 32) AT_RD(f + RD_); __builtin_amdgcn_sched_barrier(0); }
            }
#undef AT_RD
#undef AT_MM
        }
        AT_BAR();
    }
    if (!kvh) __builtin_amdgcn_s_barrier(); else __builtin_amdgcn_s_setprio(0);
#undef AT_LD
#undef AT_ST
#undef AT_QK
#undef AT_BAR
    const float lt = l_run + __shfl_xor(l_run, 32); const float inv = 1.0f / lt;
    bf16_t* op = O + qrow * 1024 + (kvh * 4 + g) * 128 + 4 * hi;
#pragma unroll
    for (int dt = 0; dt < 4; ++dt)
#pragma unroll
        for (int qd = 0; qd < 4; ++qd) { f32x4 v = {Oa[dt][4 * qd] * inv, Oa[dt][4 * qd + 1] * inv, Oa[dt][4 * qd + 2] * inv, Oa[dt][4 * qd + 3] * inv}; st_bf16x4(op + 32 * dt + 8 * qd, v); }
}

__device__ __forceinline__ void dsa_prompt_block(const Ptrs& P, LDSP unsigned char* lds, int n, int qb, int tid, int wid, int lane) {
    const bf16_t* Q = (const bf16_t*)(P.ws + WS_ACT + B_Q); const bf16_t* KB = (const bf16_t*)(P.ws + WS_ACT + B_KB); const bf16_t* VB = (const bf16_t*)(P.ws + WS_ACT + B_VB);
    const bf16_t* QI = (const bf16_t*)(P.ws + WS_ACT + B_QI); const bf16_t* KI = (const bf16_t*)(P.ws + WS_ACT + B_KI); const float* WI = (const float*)(P.ws + WS_ACT + B_WI);
    bf16_t* O = (bf16_t*)(P.ws + WS_ACT + B_O);
    LDSP unsigned* sc = (LDSP unsigned*)lds; LDSP unsigned long long* maskL = (LDSP unsigned long long*)(lds + MASK_OFF);
    const int rowbase = n * SEQ, q0 = 32 * qb, nkt = qb + 1;
    LDSP float* wtab = (LDSP float*)(lds + 16 * SCS * 4);
    bf16x8 Af[4][4];
    index_load_A(Af, QI, rowbase, q0);
    if (tid < 256) wtab[tid] = WI[(size_t)(rowbase + q0) * 8 + tid] * IDXS;
    __syncthreads();
#if defined(MK_PROBE_IDX)
    for (int rep_ = 0; rep_ < 2; ++rep_)
#endif
    for (int sub = 0; sub < 2; ++sub) {
        const int qa = q0 + 16 * sub;
        if (sub == 1) index_load_A(Af, QI, rowbase, qa);
        index_prompt(sc, (const LDSP f32x4*)(wtab + 128 * sub), Af, KI, rowbase, qa, nkt, wid, lane);
        __syncthreads();
#if defined(MK_PROBE_SEL)
        for (int rep2_ = 0; rep2_ < 2; ++rep2_)
#endif
#pragma unroll 1
        for (int rr = 0; rr < 2; ++rr) { const int ql = 2 * wid + rr; select_row(sc + ql * SCS, 32 * nkt, qa + ql + 1, maskL + (16 * sub + ql) * MASK_STRIDE, (LDSP unsigned*)(lds + SEL_OFF) + 320 * wid); }
        __syncthreads();
    }
#if defined(MK_PROBE_ATT)
    attn_qblock(lds, maskL, Q, KB, VB, O, rowbase, q0, (qb >> 1) + 1, tid, wid, lane);
    __syncthreads();
#endif
    attn_qblock(lds, maskL, Q, KB, VB, O, rowbase, q0, (qb >> 1) + 1, tid, wid, lane);
    __syncthreads();
}

__device__ __forceinline__ void dsa_sample_item(const Ptrs& P, LDSP unsigned char* lds, int jB, int nd, int tp, int tid, int wid, int lane) {
    const bf16_t* Q = (const bf16_t*)(P.ws + WS_ACT + B_Q); const bf16_t* QI = (const bf16_t*)(P.ws + WS_ACT + B_QI); const bf16_t* KI = (const bf16_t*)(P.ws + WS_ACT + B_KI);
    const float* WI = (const float*)(P.ws + WS_ACT + B_WI); bf16_t* O = (bf16_t*)(P.ws + WS_ACT + B_O);
    LDSP unsigned* sc = (LDSP unsigned*)lds; LDSP unsigned long long* maskL = (LDSP unsigned long long*)(lds + MASK_OFF);
    LDSP int* list = (LDSP int*)(lds + 17408); LDSP int* pt = (LDSP int*)(lds + 19456);
    LDSP f32x4* sS = (LDSP f32x4*)(lds + 20480); LDSP f32x4* Opart = (LDSP f32x4*)(lds + 36864); LDSP float* ML = (LDSP float*)(lds + 69632);
    const int t0 = 2 * tp;
    index_sample(sc, QI, WI, KI, P.cache_kidx + (size_t)jB * NPOOL * 128 * 64, pt, P.page_table, tid, nd, t0, wid, lane);
    __syncthreads();
    const int ql = wid >> 2, part = wid & 3, t = t0 + ql;
    const int kvh = lane >> 5, l31 = lane & 31;
    const size_t qrow = (size_t)(TP + 4 * nd + t);
    u32x2 qraw[4];
#pragma unroll
    for (int g = 0; g < 4; ++g) qraw[g] = *(const u32x2*)(Q + qrow * 1024 + (kvh * 4 + g) * 128 + 4 * l31);
    asm volatile("" ::: "memory");
    if (wid < 2) {
        select_row(sc + wid * SCS, 65 * 32, SEQ + t0 + wid + 1, maskL + wid * MASK_STRIDE, (LDSP unsigned*)(lds + SEL_OFF) + 320 * wid);
        int base = 0;
        for (int r = 0; r < 33; ++r) { const unsigned long long w = maskL[wid * MASK_STRIDE + r];
            const int pre = (int)__builtin_amdgcn_mbcnt_hi((unsigned)(w >> 32), __builtin_amdgcn_mbcnt_lo((unsigned)w, 0u));
            if ((w >> lane) & 1ull) { const int p = base + pre; if (p < KTOP) list[wid * KTOP + p] = 64 * r + lane; }
            base += __builtin_popcountll(w); }
    }
    __syncthreads();
    f32x4 qv[4];
#pragma unroll
    for (int g = 0; g < 4; ++g) { const u32x2 w = qraw[g]; qv[g] = (f32x4){bf_lo(w.x), bf_hi(w.x), bf_lo(w.y), bf_hi(w.y)}; }
    const int myidx = list[ql * KTOP + 64 * part + lane];
    const float* ck = P.cache_k + (size_t)jB * NPOOL * 128 * 256; const float* cv = P.cache_v + (size_t)jB * NPOOL * 128 * 256;
    const float* nk = P.out + O_NKS + (size_t)jB * TS * 256; const float* nv = P.out + O_NVS + (size_t)jB * TS * 256;
    float mrun[4], lrun[4]; f32x4 oa[4];
#pragma unroll
    for (int g = 0; g < 4; ++g) { mrun[g] = -1e30f; lrun[g] = 0.f; oa[g] = (f32x4){0.f, 0.f, 0.f, 0.f}; }
#define SA_LOAD(kr, vr, b_) do { _Pragma("unroll") for (int j = 0; j < 4; ++j) { const int idx = __builtin_amdgcn_readlane(myidx, 4 * (b_) + j); \
            const bool past = idx < SEQ; const size_t ro = past ? ((size_t)pt[idx >> 7] * 128 + (idx & 127)) * 256 : (size_t)(4 * nd + idx - SEQ) * 256; \
            kr[j] = *(const f32x4*)((past ? ck : nk) + ro + 4 * lane); vr[j] = *(const f32x4*)((past ? cv : nv) + ro + 4 * lane); } } while (0)
#define SA_STEP(kr, vr) do { \
        float sc4[4][4]; \
        _Pragma("unroll") for (int j = 0; j < 4; ++j) \
            _Pragma("unroll") for (int g = 0; g < 4; ++g) { float d = (qv[g][0] * kr[j][0] + qv[g][1] * kr[j][1]) + (qv[g][2] * kr[j][2] + qv[g][3] * kr[j][3]); \
                d += __int_as_float(__builtin_amdgcn_update_dpp(0, __float_as_int(d), 0xB1, 0xF, 0xF, false)); d += __int_as_float(__builtin_amdgcn_update_dpp(0, __float_as_int(d), 0x4E, 0xF, 0xF, false)); \
                d += __int_as_float(__builtin_amdgcn_update_dpp(0, __float_as_int(d), 0x141, 0xF, 0xF, false)); d += __int_as_float(__builtin_amdgcn_update_dpp(0, __float_as_int(d), 0x140, 0xF, 0xF, false)); \
                d += __shfl_xor(d, 16); sc4[j][g] = d; } \
        _Pragma("unroll") for (int g = 0; g < 4; ++g) { \
            const float mb = fmaxf(fmaxf(sc4[0][g], sc4[1][g]), fmaxf(sc4[2][g], sc4[3][g])); \
            const float mn = fmaxf(mrun[g], mb), alpha = __builtin_amdgcn_exp2f(mrun[g] - mn); mrun[g] = mn; \
            float ps = 0.f; f32x4 o = oa[g] * alpha; \
            _Pragma("unroll") for (int j = 0; j < 4; ++j) { const float pj = __builtin_amdgcn_exp2f(sc4[j][g] - mn); ps += pj; o += vr[j] * pj; } \
            oa[g] = o; lrun[g] = lrun[g] * alpha + ps; \
        } } while (0)
    {
        f32x4 kra[4], vra[4], krb[4], vrb[4], krc[4], vrc[4];
        SA_LOAD(kra, vra, 0); SA_LOAD(krb, vrb, 1); SA_LOAD(krc, vrc, 2);
#pragma unroll 1
        for (int b = 0; b < 16; b += 3) {
            SA_STEP(kra, vra); if (b + 3 < 16) SA_LOAD(kra, vra, b + 3);
            if (b + 1 < 16) { SA_STEP(krb, vrb); if (b + 4 < 16) SA_LOAD(krb, vrb, b + 4); }
            if (b + 2 < 16) { SA_STEP(krc, vrc); if (b + 5 < 16) SA_LOAD(krc, vrc, b + 5); }
        }
    }
#undef SA_LOAD
#undef SA_STEP
#pragma unroll
    for (int g = 0; g < 4; ++g) Opart[(wid * 64 + lane) * 4 + g] = oa[g];
    if (l31 == 0) {
#pragma unroll
        for (int g = 0; g < 4; ++g) { ML[((wid * 2 + kvh) * 4 + g) * 2] = mrun[g]; ML[((wid * 2 + kvh) * 4 + g) * 2 + 1] = lrun[g]; }
    }
    __syncthreads();
    if (part == 0) {
        f32x4 acc4[4]; float M[4], L[4];
#pragma unroll
        for (int g = 0; g < 4; ++g) { M[g] = -INFINITY; L[g] = 0.f; acc4[g] = (f32x4){0.f, 0.f, 0.f, 0.f}; }
#pragma unroll
        for (int pp = 0; pp < 4; ++pp)
#pragma unroll
            for (int g = 0; g < 4; ++g) M[g] = fmaxf(M[g], ML[(((ql * 4 + pp) * 2 + kvh) * 4 + g) * 2]);
#pragma unroll
        for (int pp = 0; pp < 4; ++pp)
#pragma unroll
            for (int g = 0; g < 4; ++g) { const float m = ML[(((ql * 4 + pp) * 2 + kvh) * 4 + g) * 2], l = ML[(((ql * 4 + pp) * 2 + kvh) * 4 + g) * 2 + 1];
                const float f = __builtin_amdgcn_exp2f(m - M[g]); L[g] += l * f; acc4[g] += Opart[((ql * 4 + pp) * 64 + lane) * 4 + g] * f; }
#pragma unroll
        for (int g = 0; g < 4; ++g) st_bf16x4(O + qrow * 1024 + (kvh * 4 + g) * 128 + 4 * l31, acc4[g] * (1.0f / L[g]));
    }
    __syncthreads();
}

constexpr int N_PHASES = 22;
struct Args { const void* in[18]; float* out; unsigned char* ws; float invA[16]; float invI[8]; int ph_lo, ph_hi; };
static_assert(sizeof(Args) == 18 * 8 + 8 + 8 + 64 + 32 + 8, "Args has no padding");

__global__ void __launch_bounds__(512, 2) mk_fwd(Args args) {
    extern __shared__ __attribute__((aligned(16))) unsigned char lds_raw[];
    LDSP unsigned char* lds = (LDSP unsigned char*)lds_raw;
    const int wid0 = __builtin_amdgcn_readfirstlane((int)threadIdx.x >> 6);
    int lane, tid, wid;
#define FRESH_TID() do { wid = wid0; asm volatile("" : "+s"(wid)); asm volatile("v_mbcnt_lo_u32_b32 %0, -1, 0\n\tv_mbcnt_hi_u32_b32 %0, -1, %0" : "=v"(lane)); tid = wid * 64 + lane; } while (0)
    FRESH_TID();
    const int G = gridDim.x, bx = blockIdx.x;
    const int vcu = (G % 8 == 0) ? (bx % 8) * (G / 8) + bx / 8 : bx;
    const int NGW = G * 8;
    for (int u = tid; u < (LDS_BYTES - MISC_OFF) / 4; u += 512) ((LDSP unsigned*)(lds + MISC_OFF))[u] = 0u;
    __syncthreads();
    {
#pragma unroll
        for (int k = 0; k < 18; ++k) if (tid == k) *(LDSP unsigned long long*)(lds + MISC_OFF + 256 + 8 * k) = (unsigned long long)args.in[k];
    }
    __syncthreads();
#define LDPTR(k) ((const void*)(((unsigned long long)(unsigned)__builtin_amdgcn_readlane((int)phi_, (k)) << 32) | (unsigned long long)(unsigned)__builtin_amdgcn_readlane((int)plo_, (k))))
#define LOAD_P() Ptrs P; do { const unsigned long long pv_ = *(volatile LDSP unsigned long long*)(lds + MISC_OFF + 256 + 8 * (lane < 18 ? lane : 0)); const unsigned plo_ = (unsigned)pv_, phi_ = (unsigned)(pv_ >> 32); \
    P.xp = (const float*)LDPTR(0); P.xs = (const float*)LDPTR(1); P.cache_k = (const float*)LDPTR(2); P.cache_v = (const float*)LDPTR(3); P.cache_kidx = (const float*)LDPTR(4); \
    P.page_table = (const int*)LDPTR(5); P.norm_mix = (const float*)LDPTR(6); P.norm_ffn = (const float*)LDPTR(7); P.a_w_in = (const float*)LDPTR(8); P.a_v_gain = (const float*)LDPTR(9); \
    P.a_w_s = (const float*)LDPTR(10); P.a_b_s = (const float*)LDPTR(11); P.a_w_out = (const float*)LDPTR(12); P.b_w_in = (const float*)LDPTR(13); P.b_w_out = (const float*)LDPTR(14); \
    P.ffn_w1 = (const float*)LDPTR(15); P.ffn_w2 = (const float*)LDPTR(16); P.norm_final = (const float*)LDPTR(17); P.out = args.out; P.ws = args.ws; } while (0)
    XcdBarrier bar = xcd_barrier_post((unsigned*)(args.ws + WS_CTL) + CW_BAR, (volatile LAS unsigned*)(lds + MISC_OFF + 32));
#define BXL() ({ int b_ = bx; asm volatile("" : "+s"(b_)); b_; })
#if defined(MK_PROBE_BAR)
#define MK_EXTRA_BAR xcd_barrier(b_);
#else
#define MK_EXTRA_BAR
#endif
#ifndef MK_LAST_PHASE
#define MK_LAST_PHASE 21
#endif
#define IN(k) ((k) <= MK_LAST_PHASE)
#define SEAM(k) do { if ((k) + 1 <= MK_LAST_PHASE) { XcdBarrier b_ = bar; asm volatile("" : "+s"(b_.bar), "+s"(b_.x)); xcd_barrier(b_); MK_EXTRA_BAR } } while (0)

    unsigned char* const ws = args.ws;
    bf16_t* xb = (bf16_t*)(ws + WS_XB); float* ssq = (float*)(ws + WS_SSQ);
    bf16_t* act = (bf16_t*)(ws + WS_ACT);

    if (IN(0)) {
        float myinv = 0.f;
#pragma unroll
        for (int k = 0; k < 16; ++k) if (lane == k) myinv = args.invA[k];
#pragma unroll
        for (int k = 0; k < 8; ++k) if (lane == 16 + k) myinv = args.invI[k];
        LOAD_P(); prologue(P, lds, myinv, vcu * 8 + wid, NGW, wid, lane);
#if defined(MK_PROBE_PRO)
        __syncthreads(); prologue(P, lds, myinv, vcu * 8 + wid, NGW, wid, lane);
#endif
    }
    SEAM(0);

    for (int layer = 0; layer < 4; ++layer) {
        const int j = layer >> 1, ph = 1 + 5 * layer;
        if ((layer & 1) == 0) {
            if (IN(ph)) {
                pg8::Gemm g{xb, (const bf16_t*)(ws + WS_WAIN) + (size_t)j * 2048 * D, TP, 2048, D}; pg8::StaticOrder S; S.init(TP, 2048, G, BXL());
                EpiA1 E{ssq, (bf16_t*)(ws + WS_ACT + A_UB), (bf16_t*)(ws + WS_ACT + A_VB), (float*)(ws + WS_X)};
                auto small_ = [&]() __attribute__((always_inline)) {
                { SEpiA1 Es{ssq, (bf16_t*)(ws + WS_ACT + A_UB), (bf16_t*)(ws + WS_ACT + A_VB)}; gemm_small<64, 64, SEpiA1>(lds, g.A, g.Bt, D, TP, 8, 0, 32, Es, ssq, BXL(), G, wid0);
#if (MK_PROBE_SMALL & 1)
                  gemm_small<64, 64, SEpiA1>(lds, g.A, g.Bt, D, TP, 8, 0, 32, Es, ssq, BXL(), G, wid0);
#endif
                }
                };
                const bool small_first_ = ((BXL() >> 4) & 1) != 0;
                if (small_first_) { small_(); __syncthreads(); }
                pg8::gemm_phase<EpiA1, pg8::StaticOrder, true, true>(lds, g, S, E, wid0);
#if defined(MK_PROBE_MIXG)
                __syncthreads(); pg8::gemm_phase<EpiA1, pg8::StaticOrder, true, true>(lds, g, S, E, wid0);
#endif
                if (!small_first_) small_();
            }
            SEAM(ph);
            if (IN(ph + 1)) {
                FRESH_TID(); LOAD_P();
#if defined(MK_PROBE_MIX)
                for (int rep4_ = 0; rep4_ < 2; ++rep4_)
#endif
                for (int u = bx; u < 256; u += G) mix_prompt(P, lds, (const float*)(ws + WS_X), j, (u & 7) * 32 + (u >> 3), tid, wid, lane);
                for (int u = bx; u < 128; u += G) mix_sample(P, lds, j, u, tid, wid, lane);
            }
            SEAM(ph + 1);
            if (IN(ph + 2)) {
                pg8::Gemm g{(const bf16_t*)(ws + WS_ACT + A_UM), (const bf16_t*)(ws + WS_WAOUT) + (size_t)j * D * D, TP, D, D}; pg8::StaticOrder S; S.init(TP, D, G, BXL());
                EpiRes E{xb, ssq};
#if defined(MK_PROBE_MIXG)
                { EpiRes Ed{(bf16_t*)(ws + WS_X + 8 * MiB), (float*)(ws + WS_X + 48 * MiB)}; pg8::gemm_phase<EpiRes, pg8::StaticOrder, true, true>(lds, g, S, Ed, wid0); __syncthreads(); }
#endif
                auto small_ = [&]() __attribute__((always_inline)) {
                { SEpiRes Es{xb};
#if (MK_PROBE_SMALL & 2)
                  { SEpiRes Ed{(bf16_t*)(ws + WS_X + 8 * MiB)}; gemm_small<32, 64, SEpiRes>(lds, g.A, g.Bt, g.K, TP, 16, 0, 16, Ed, (float*)(ws + WS_X + 48 * MiB), BXL(), G, wid0); }
#endif
                  gemm_small<32, 64, SEpiRes>(lds, g.A, g.Bt, g.K, TP, 16, 0, 16, Es, ssq, BXL(), G, wid0); }
                };
                const bool small_first_ = ((BXL() >> 4) & 1) != 0;
                if (small_first_) { small_(); __syncthreads(); }
                pg8::gemm_phase<EpiRes, pg8::StaticOrder, true, true>(lds, g, S, E, wid0);
                if (!small_first_) small_();
            }
            SEAM(ph + 2);
        } else {
            if (IN(ph)) {
                pg8::Gemm g{xb, (const bf16_t*)(ws + WS_WBIN) + (size_t)j * NBPAD * D, TP, 2048, D}; pg8::StaticOrder S; S.init(TP, 2048, G, BXL());
                EpiB1 E{ws, args.out, j};
                auto small_ = [&]() __attribute__((always_inline)) {
                { SEpiB1 Es{ws, args.out, j};
#if (MK_PROBE_SMALL & 4)
#pragma unroll 1
                  for (int pass = 0; pass < 2; ++pass) { gemm_small<64, 64, SEpiB1>(lds, g.A, g.Bt, D, TP, 8, 0, 32, Es, ssq, BXL(), G, wid0); gemm_small<64, 128, SEpiB1>(lds, g.A, g.Bt, D, 0, T / 64, 2048, 1, Es, ssq, BXL(), G, wid0); }
#else
                  gemm_small<64, 64, SEpiB1>(lds, g.A, g.Bt, D, TP, 8, 0, 32, Es, ssq, BXL(), G, wid0); gemm_small<64, 128, SEpiB1>(lds, g.A, g.Bt, D, 0, T / 64, 2048, 1, Es, ssq, BXL(), G, wid0);
#endif
                }
                };
                const bool small_first_ = ((BXL() >> 4) & 1) != 0;
                if (small_first_) { small_(); __syncthreads(); }
                pg8::gemm_phase<EpiB1, pg8::StaticOrder, true, true>(lds, g, S, E, wid0);
#if defined(MK_PROBE_MIXG)
                __syncthreads(); pg8::gemm_phase<EpiB1, pg8::StaticOrder, true, true>(lds, g, S, E, wid0);
#endif
                if (!small_first_) small_();
            }
            SEAM(ph);
            if (IN(ph + 1)) {
                FRESH_TID(); LOAD_P();
                const bool sample_first = ((BXL() >> 4) & 1) != 0;
                if (sample_first) { FRESH_TID();
                    for (int u = bx; u < 256; u += G) dsa_sample_item(P, lds, j, (u & 7) * 16 + (u >> 4), (u >> 3) & 1, tid, wid, lane); }
                FRESH_TID();
#if defined(MK_PROBE_DSA)
                for (int rep_ = 0; rep_ < 2; ++rep_)
#endif
                for (int u = bx; u < 256; u += G) { const int n = u & 7, i = u >> 3;
#pragma unroll 1
                    for (int pass = 0; pass < 2; ++pass) dsa_prompt_block(P, lds, n, pass ? 63 - i : i, tid, wid, lane); }
                if (!sample_first) { FRESH_TID();
#if defined(MK_PROBE_SMP)
                    for (int rep3_ = 0; rep3_ < 2; ++rep3_)
#endif
                    for (int u = bx; u < 256; u += G) dsa_sample_item(P, lds, j, (u & 7) * 16 + (u >> 4), (u >> 3) & 1, tid, wid, lane); }
            }
            SEAM(ph + 1);
            if (IN(ph + 2)) {
                pg8::Gemm g{(const bf16_t*)(ws + WS_ACT + B_O), (const bf16_t*)(ws + WS_WBOUT) + (size_t)j * D * D, TP, D, D}; pg8::StaticOrder S; S.init(TP, D, G, BXL());
                EpiRes E{xb, ssq};
#if defined(MK_PROBE_MIXG)
                { EpiRes Ed{(bf16_t*)(ws + WS_X + 8 * MiB), (float*)(ws + WS_X + 48 * MiB)}; pg8::gemm_phase<EpiRes, pg8::StaticOrder, true, true>(lds, g, S, Ed, wid0); __syncthreads(); }
#endif
                auto small_ = [&]() __attribute__((always_inline)) {
                { SEpiRes Es{xb};
#if (MK_PROBE_SMALL & 2)
                  { SEpiRes Ed{(bf16_t*)(ws + WS_X + 8 * MiB)}; gemm_small<32, 64, SEpiRes>(lds, g.A, g.Bt, g.K, TP, 16, 0, 16, Ed, (float*)(ws + WS_X + 48 * MiB), BXL(), G, wid0); }
#endif
                  gemm_small<32, 64, SEpiRes>(lds, g.A, g.Bt, g.K, TP, 16, 0, 16, Es, ssq, BXL(), G, wid0); }
                };
                const bool small_first_ = ((BXL() >> 4) & 1) != 0;
                if (small_first_) { small_(); __syncthreads(); }
                pg8::gemm_phase<EpiRes, pg8::StaticOrder, true, true>(lds, g, S, E, wid0);
                if (!small_first_) small_();
            }
            SEAM(ph + 2);
        }
        if (IN(ph + 3)) {
            pg8::Gemm g{xb, (const bf16_t*)(ws + WS_W1) + (size_t)layer * FF * D, TP, FF, D}; pg8::StaticOrder S; S.init(TP, FF, G, BXL());
            EpiF1 E{ssq, act};
            auto small_ = [&]() __attribute__((always_inline)) {
            { SEpiF1 Es{ssq, act}; gemm_small<64, 128, SEpiF1>(lds, g.A, g.Bt, D, TP, 8, 0, 32, Es, ssq, BXL(), G, wid0);
#if (MK_PROBE_SMALL & 8)
              gemm_small<64, 128, SEpiF1>(lds, g.A, g.Bt, D, TP, 8, 0, 32, Es, ssq, BXL(), G, wid0);
#endif
            }
            };
            const bool small_first_ = ((BXL() >> 4) & 1) != 0;
            if (small_first_) { small_(); __syncthreads(); }
            pg8::gemm_phase<EpiF1, pg8::StaticOrder, true, true>(lds, g, S, E, wid0);
#if defined(MK_PROBE_F1)
            __syncthreads(); pg8::gemm_phase<EpiF1, pg8::StaticOrder, true, true>(lds, g, S, E, wid0);
#endif
            if (!small_first_) small_();
        }
        SEAM(ph + 3);
        if (IN(ph + 4)) {
            pg8::Gemm g{act, (const bf16_t*)(ws + WS_W2) + (size_t)layer * D * FF, TP, D, FF}; pg8::StaticOrder S; S.init(TP, D, G, BXL());
            EpiRes E{xb, ssq};
#if defined(MK_PROBE_F2)
            { EpiRes Ed{(bf16_t*)(ws + WS_X), (float*)(ws + WS_X + 40 * MiB)}; pg8::gemm_phase<EpiRes, pg8::StaticOrder, true, true>(lds, g, S, Ed, wid0); __syncthreads(); }
#endif
            auto small_ = [&]() __attribute__((always_inline)) {
            { SEpiRes Es{xb};
#if (MK_PROBE_SMALL & 16)
                  { SEpiRes Ed{(bf16_t*)(ws + WS_X + 8 * MiB)}; gemm_small<32, 64, SEpiRes>(lds, g.A, g.Bt, g.K, TP, 16, 0, 16, Ed, (float*)(ws + WS_X + 48 * MiB), BXL(), G, wid0); }
#endif
                  gemm_small<32, 64, SEpiRes>(lds, g.A, g.Bt, g.K, TP, 16, 0, 16, Es, ssq, BXL(), G, wid0); }
            };
            const bool small_first_ = ((BXL() >> 4) & 1) != 0;
            if (small_first_) { small_(); __syncthreads(); }
            pg8::gemm_phase<EpiRes, pg8::StaticOrder, true, true>(lds, g, S, E, wid0);
            if (!small_first_) small_();
        }
        SEAM(ph + 4);
    }
    if (IN(21)) { FRESH_TID(); LOAD_P(); final_norm(P, vcu * 8 + wid, NGW, lane); }
#undef IN
#undef SEAM
#undef FRESH_TID
#undef BXL
#undef LOAD_P
#undef LDPTR
}
}

extern "C" void kernel_launch(void* const* d_in, const int* in_sizes, int n_in, void* d_out, int out_size, void* d_ws, size_t ws_size, hipStream_t stream) {
    static int grid = 0;
    if (grid == 0) {
        if (n_in != 18 || out_size != (int)mk::O_END || ws_size < mk::WS_END) { fprintf(stderr, "kernel_launch: unexpected problem (n_in %d, out %d, ws %zu); nothing launched\n", n_in, out_size, ws_size); grid = -1; return; }
        int dev = 0, cus = 0, per_cu = 0;
        if (hipGetDevice(&dev) != hipSuccess || hipDeviceGetAttribute(&cus, hipDeviceAttributeMultiprocessorCount, dev) != hipSuccess) { grid = -1; return; }
        if (hipFuncSetAttribute((const void*)mk::mk_fwd, hipFuncAttributeMaxDynamicSharedMemorySize, mk::LDS_BYTES) != hipSuccess) { fprintf(stderr, "kernel_launch: hipFuncSetAttribute failed\n"); grid = -1; return; }
        if (hipOccupancyMaxActiveBlocksPerMultiprocessor(&per_cu, (const void*)mk::mk_fwd, 512, mk::LDS_BYTES) != hipSuccess || per_cu < 1)
            fprintf(stderr, "kernel_launch: note: occupancy query reports %d workgroups per CU\n", per_cu);
        (void)hipGetLastError();
        grid = cus;
    }
    if (grid < 0) return;
    if (hipMemsetAsync((char*)d_ws + mk::WS_CTL, 0, mk::CTL_ZERO_BYTES, stream) != hipSuccess) { fprintf(stderr, "kernel_launch: memset failed\n"); return; }
    mk::Args a{};
    for (int i = 0; i < 18; ++i) a.in[i] = d_in[i];
    a.out = (float*)d_out; a.ws = (unsigned char*)d_ws;
    for (int i = 0; i < 16; ++i) a.invA[i] = (float)pow(500000.0, -(double)i / 16.0);
    for (int i = 0; i < 8; ++i) a.invI[i] = (float)pow(500000.0, -(double)i / 8.0);
    a.ph_lo = 0; a.ph_hi = mk::N_PHASES;
    hipLaunchKernelGGL(mk::mk_fwd, dim3(grid), dim3(512), mk::LDS_BYTES, stream, a);
    const hipError_t le = hipPeekAtLastError();
    if (le != hipSuccess) fprintf(stderr, "kernel_launch: launch failed: %s\n", hipGetErrorName(le));
}
```
